# Optimizing an MI355X kernel written in HIP

```python
import math
import jax, jax.numpy as jnp
from jax import lax
import numpy as np

D_MODEL = 1024
BATCH = 8
SEQ = 4096
DEPTH = 2
DEC_BATCH = 4
DEC_SEQ = 4096
PAST_LEN = 128

N_MEM = 256
MEM_HEADS = 4
MEM_HEAD_DIM = 128
MEM_WIDTH = MEM_HEADS * MEM_HEAD_DIM

MLA_HEADS = 8
MLA_Q_RANK = 384
MLA_KV_RANK = 256
MLA_NOPE = 128
MLA_ROPE = 64
MLA_V = 128
MLA_QK = MLA_NOPE + MLA_ROPE
ROPE_THETA = 10000.0

SWA_HEADS = 16
SWA_KV_HEADS = 2
SWA_HEAD_DIM = 64
SWA_GROUP = SWA_HEADS // SWA_KV_HEADS
WINDOW = 128
BLOCK = 128

MIX_WIDTH = 1024
BRANCH_WIDTH = MIX_WIDTH + MEM_WIDTH
EPS = 1e-6
NEG = -1e30

N_A = (DEPTH + 1) // 2
N_B = DEPTH // 2

IN_A = MLA_Q_RANK + MLA_KV_RANK + MLA_ROPE + MEM_WIDTH + BRANCH_WIDTH
SPLIT_A = (MLA_Q_RANK, MLA_Q_RANK + MLA_KV_RANK, MLA_Q_RANK + MLA_KV_RANK + MLA_ROPE,
           MLA_Q_RANK + MLA_KV_RANK + MLA_ROPE + MEM_WIDTH)
SWA_Q_W = SWA_HEADS * SWA_HEAD_DIM
SWA_KV_W = SWA_KV_HEADS * SWA_HEAD_DIM
IN_B = SWA_Q_W + 2 * SWA_KV_W + MEM_WIDTH + BRANCH_WIDTH
SPLIT_B = (SWA_Q_W, SWA_Q_W + SWA_KV_W, SWA_Q_W + 2 * SWA_KV_W, SWA_Q_W + 2 * SWA_KV_W + MEM_WIDTH)

kernel_name = 'hybrid_mla_swa_memory_encoder'


def rmsnorm(x, g):
    x32 = x.astype(jnp.float32)
    y = x32 * lax.rsqrt(jnp.mean(x32 * x32, axis=-1, keepdims=True) + EPS)
    return (y * g.astype(jnp.float32)).astype(x.dtype)


def rope_tables(seq):
    inv = 1.0 / (ROPE_THETA ** (jnp.arange(0, MLA_ROPE, 2, dtype=jnp.float32) / MLA_ROPE))
    ang = jnp.arange(seq, dtype=jnp.float32)[:, None] * inv[None, :]
    return jnp.cos(ang), jnp.sin(ang)


def apply_rope(x, cos, sin):
    half = x.shape[-1] // 2
    x1, x2 = x[..., :half], x[..., half:]
    c = cos.astype(x.dtype)
    s = sin.astype(x.dtype)
    return jnp.concatenate([x1 * c - x2 * s, x2 * c + x1 * s], axis=-1)


def alibi_slopes(n):
    return 2.0 ** (-8.0 * jnp.arange(1, n + 1, dtype=jnp.float32) / n)


def mla_mixer(c_q, c_kv, k_r, q_a_norm, w_q_b, kv_a_norm, w_kv_b, q_norm, k_norm):
    B, S, _ = c_q.shape
    q = (rmsnorm(c_q, q_a_norm) @ w_q_b).reshape(B, S, MLA_HEADS, MLA_QK)
    kv = (rmsnorm(c_kv, kv_a_norm) @ w_kv_b).reshape(B, S, MLA_HEADS, MLA_NOPE + MLA_V)
    k_nope, v = kv[..., :MLA_NOPE], kv[..., MLA_NOPE:]
    k = jnp.concatenate([k_nope, jnp.broadcast_to(k_r[:, :, None, :], (B, S, MLA_HEADS, MLA_ROPE))], axis=-1)
    q = rmsnorm(q, q_norm)
    k = rmsnorm(k, k_norm)
    cos, sin = rope_tables(S)
    cos, sin = cos[None, :, None, :], sin[None, :, None, :]
    q = jnp.concatenate([q[..., :MLA_NOPE], apply_rope(q[..., MLA_NOPE:], cos, sin)], axis=-1)
    k = jnp.concatenate([k[..., :MLA_NOPE], apply_rope(k[..., MLA_NOPE:], cos, sin)], axis=-1)
    nq = S // BLOCK
    qb = q.reshape(B, nq, BLOCK, MLA_HEADS, MLA_QK).transpose(1, 0, 2, 3, 4)
    scale = MLA_QK ** -0.5

    def attend(q_blk):
        s = jnp.einsum('bqhd,bkhd->bhqk', q_blk, k).astype(jnp.float32) * scale
        p = jax.nn.softmax(s, axis=-1).astype(v.dtype)
        return jnp.einsum('bhqk,bkhd->bqhd', p, v)

    o = lax.map(attend, qb)
    return o.transpose(1, 0, 2, 3, 4).reshape(B, S, MLA_HEADS * MLA_V)


def swa_mixer(q, k, v, q_norm, k_norm, sink):
    B, S, _ = q.shape
    q = rmsnorm(q.reshape(B, S, SWA_HEADS, SWA_HEAD_DIM), q_norm)
    k = rmsnorm(k.reshape(B, S, SWA_KV_HEADS, SWA_HEAD_DIM), k_norm)
    v = v.reshape(B, S, SWA_KV_HEADS, SWA_HEAD_DIM)
    nq = S // BLOCK
    pad = ((0, 0), (BLOCK, BLOCK), (0, 0), (0, 0))
    kp = jnp.pad(k, pad)
    vp = jnp.pad(v, pad)
    qb = q.reshape(B, nq, BLOCK, SWA_KV_HEADS, SWA_GROUP, SWA_HEAD_DIM).transpose(1, 0, 2, 3, 4, 5)
    slopes = alibi_slopes(SWA_HEADS).reshape(SWA_KV_HEADS, SWA_GROUP)[None, :, :, None, None]
    sink_l = sink.astype(jnp.float32).reshape(SWA_KV_HEADS, SWA_GROUP)[None, :, :, None, None]
    rel = jnp.arange(3 * BLOCK)[None, :] - BLOCK - jnp.arange(BLOCK)[:, None]
    dist = jnp.abs(rel).astype(jnp.float32)
    in_window = jnp.abs(rel) <= WINDOW
    scale = SWA_HEAD_DIM ** -0.5

    def attend(args):
        i, q_blk = args
        start = i * BLOCK
        k_blk = lax.dynamic_slice_in_dim(kp, start, 3 * BLOCK, axis=1)
        v_blk = lax.dynamic_slice_in_dim(vp, start, 3 * BLOCK, axis=1)
        key_pos = start - BLOCK + jnp.arange(3 * BLOCK)
        valid = in_window & ((key_pos >= 0) & (key_pos < S))[None, :]
        s = jnp.einsum('bqkgd,bjkd->bkgqj', q_blk, k_blk).astype(jnp.float32) * scale
        s = jnp.where(valid, s - slopes * dist, NEG)
        sk = jnp.broadcast_to(sink_l, s.shape[:-1] + (1,))
        p = jax.nn.softmax(jnp.concatenate([s, sk], axis=-1), axis=-1)[..., :-1]
        return jnp.einsum('bkgqj,bjkd->bqkgd', p.astype(v_blk.dtype), v_blk)

    o = lax.map(attend, (jnp.arange(nq), qb))
    return o.transpose(1, 0, 2, 3, 4, 5).reshape(B, S, SWA_Q_W)


def memory_attention(q, mem, mem_norm, w_mem_kv, q_norm, k_norm):
    B, S, _ = q.shape
    q = rmsnorm(q.reshape(B, S, MEM_HEADS, MEM_HEAD_DIM), q_norm)
    kv = rmsnorm(mem, mem_norm) @ w_mem_kv
    k = rmsnorm(kv[..., :MEM_WIDTH].reshape(B, N_MEM, MEM_HEADS, MEM_HEAD_DIM), k_norm)
    v = kv[..., MEM_WIDTH:].reshape(B, N_MEM, MEM_HEADS, MEM_HEAD_DIM)
    s = jnp.einsum('bshd,bnhd->bhsn', q, k).astype(jnp.float32) * (MEM_HEAD_DIM ** -0.5)
    p = jax.nn.softmax(s, axis=-1).astype(v.dtype)
    return jnp.einsum('bhsn,bnhd->bshd', p, v).reshape(B, S, MEM_WIDTH)


def trunk(x, mem, p):
    for i in range(DEPTH):
        h = rmsnorm(x, p['norm_in'][i])
        j = i // 2
        if i % 2 == 0:
            z = h @ p['a_w_in'][j]
            c_q, c_kv, k_r, q_mem, gate = jnp.split(z, SPLIT_A, axis=-1)
            mix = mla_mixer(c_q, c_kv, k_r, p['a_q_a_norm'][j], p['a_w_q_b'][j],
                            p['a_kv_a_norm'][j], p['a_w_kv_b'][j], p['a_q_norm'][j], p['a_k_norm'][j])
        else:
            z = h @ p['b_w_in'][j]
            q, k, v, q_mem, gate = jnp.split(z, SPLIT_B, axis=-1)
            mix = swa_mixer(q, k, v, p['b_q_norm'][j], p['b_k_norm'][j], p['b_sink'][j])
        mem_o = memory_attention(q_mem, mem, p['mem_norm'][i], p['w_mem_kv'][i],
                                 p['mem_q_norm'][i], p['mem_k_norm'][i])
        branch = jnp.concatenate([mix, mem_o], axis=-1) * jax.nn.silu(gate)
        x = x + branch @ p['w_out'][i]
    return x


def setup_inputs(seed: int = 0) -> dict:
    key = jax.random.key(seed)
    ks = jax.random.split(key, 24)
    f32 = jnp.float32

    def nrm(k, shape, scale):
        return jax.random.normal(k, shape, f32) * scale

    def gain(k, shape):
        return 1.0 + 0.02 * jax.random.normal(k, shape, f32)

    return {
        'x_prompt': nrm(ks[0], (BATCH, SEQ, D_MODEL), 1.0),
        'x_sample': nrm(ks[1], (DEC_BATCH, DEC_SEQ, D_MODEL), 1.0),
        'mem_prompt': nrm(ks[2], (BATCH, N_MEM, D_MODEL), 1.0),
        'mem_sample': nrm(ks[3], (DEC_BATCH, N_MEM, D_MODEL), 1.0),
        'norm_in': gain(ks[4], (DEPTH, D_MODEL)),
        'w_out': nrm(ks[5], (DEPTH, BRANCH_WIDTH, D_MODEL), BRANCH_WIDTH ** -0.5),
        'mem_norm': gain(ks[6], (DEPTH, D_MODEL)),
        'w_mem_kv': nrm(ks[7], (DEPTH, D_MODEL, 2 * MEM_WIDTH), D_MODEL ** -0.5),
        'mem_q_norm': gain(ks[8], (DEPTH, MEM_HEAD_DIM)),
        'mem_k_norm': gain(ks[9], (DEPTH, MEM_HEAD_DIM)),
        'a_w_in': nrm(ks[10], (N_A, D_MODEL, IN_A), D_MODEL ** -0.5),
        'a_q_a_norm': gain(ks[11], (N_A, MLA_Q_RANK)),
        'a_w_q_b': nrm(ks[12], (N_A, MLA_Q_RANK, MLA_HEADS * MLA_QK), MLA_Q_RANK ** -0.5),
        'a_kv_a_norm': gain(ks[13], (N_A, MLA_KV_RANK)),
        'a_w_kv_b': nrm(ks[14], (N_A, MLA_KV_RANK, MLA_HEADS * (MLA_NOPE + MLA_V)), MLA_KV_RANK ** -0.5),
        'a_q_norm': gain(ks[15], (N_A, MLA_QK)),
        'a_k_norm': gain(ks[16], (N_A, MLA_QK)),
        'b_w_in': nrm(ks[17], (N_B, D_MODEL, IN_B), D_MODEL ** -0.5),
        'b_q_norm': gain(ks[18], (N_B, SWA_HEAD_DIM)),
        'b_k_norm': gain(ks[19], (N_B, SWA_HEAD_DIM)),
        'b_sink': nrm(ks[20], (N_B, SWA_HEADS), 0.5),
    }


def reference(x_prompt, x_sample, mem_prompt, mem_sample, norm_in, w_out, mem_norm, w_mem_kv,
              mem_q_norm, mem_k_norm, a_w_in, a_q_a_norm, a_w_q_b, a_kv_a_norm, a_w_kv_b,
              a_q_norm, a_k_norm, b_w_in, b_q_norm, b_k_norm, b_sink):
    p = {
        'norm_in': norm_in, 'w_out': w_out, 'mem_norm': mem_norm, 'w_mem_kv': w_mem_kv,
        'mem_q_norm': mem_q_norm, 'mem_k_norm': mem_k_norm,
        'a_w_in': a_w_in, 'a_q_a_norm': a_q_a_norm, 'a_w_q_b': a_w_q_b, 'a_kv_a_norm': a_kv_a_norm,
        'a_w_kv_b': a_w_kv_b, 'a_q_norm': a_q_norm, 'a_k_norm': a_k_norm,
        'b_w_in': b_w_in, 'b_q_norm': b_q_norm, 'b_k_norm': b_k_norm, 'b_sink': b_sink,
    }
    y_prompt = trunk(x_prompt, mem_prompt, p)
    y_sample = trunk(x_sample, mem_sample, p)
    return (y_prompt, y_sample)
```

```cpp
#include <hip/hip_runtime.h>
#include <hip/hip_bf16.h>
#include <hip/hip_cooperative_groups.h>
#include <cstdio>
#include <cstdint>
namespace cg = cooperative_groups;

#ifndef MK_COOP
#define MK_COOP 1
#endif

using bf16   = __hip_bfloat16;
using bf16x8 = __attribute__((ext_vector_type(8))) short;
using s16x4  = __attribute__((ext_vector_type(4))) short;
using f32x16 = __attribute__((ext_vector_type(16))) float;
using f32x4  = __attribute__((ext_vector_type(4))) float;
using u32x4  = __attribute__((ext_vector_type(4))) unsigned;
using u32x2  = __attribute__((ext_vector_type(2))) unsigned;
using bf2_t  = __attribute__((ext_vector_type(2))) __bf16;
#define DEVI __device__ __forceinline__
typedef const __attribute__((address_space(4))) float* cfloat_p;
#define SBAR() __builtin_amdgcn_sched_barrier(0)
#define LAUNDER_TID(tid) int tid = threadIdx.x; asm volatile("" : "+v"(tid))
#define LAUNDER_PTR(ptr) asm volatile("" : "+s"(ptr))

constexpr int NTOK = 49152, SEQ = 4096, NPROMPT_TOK = 32768;
constexpr int NMEMROW = 3072, NPROMPT_MEM = 2048;
constexpr float EPS = 1e-6f;
constexpr float LOG2E = 1.4426950408889634f;

constexpr size_t MiB = 1ull << 20;
constexpr size_t WA_BYTES = 2816ull * 1024 * 2, WB_BYTES = 3328ull * 1024 * 2, WO_BYTES = 1024ull * 1536 * 2, WM_BYTES = 1024ull * 1024 * 2;
constexpr size_t WQ_BYTES = 1536ull * 384 * 2, WKV_BYTES = 2048ull * 256 * 2, MEMKV_BYTES = 3072ull * 1024 * 2;
constexpr size_t OFF_WA = 0;
constexpr size_t OFF_WB = OFF_WA + WA_BYTES;
constexpr size_t OFF_WO = OFF_WB + WB_BYTES;
constexpr size_t OFF_WM = OFF_WO + 2 * WO_BYTES;
constexpr size_t OFF_WQ = OFF_WM + 2 * WM_BYTES;
constexpr size_t OFF_WKV = OFF_WQ + WQ_BYTES;
constexpr size_t OFF_MEMKV = OFF_WKV + WKV_BYTES;
constexpr size_t OFF_MEMB = OFF_MEMKV + 2 * MEMKV_BYTES;
constexpr size_t OFF_SS0 = OFF_MEMB + 3072ull * 1024 * 2;
constexpr size_t OFF_SS1 = OFF_SS0 + NTOK * 4ull;
constexpr size_t OFF_SSM = OFF_SS1 + NTOK * 4ull;
constexpr size_t OFF_ROPE = OFF_SSM + NMEMROW * 4ull;
constexpr size_t OFF_W_END = OFF_ROPE + 2ull * 4096 * 32 * 4;
static_assert(OFF_W_END <= 60 * MiB, "weight region overflow");
constexpr size_t OFF_XB = 60 * MiB, OFF_Q0 = 60 * MiB, OFF_K0 = 204 * MiB, OFF_V0 = 348 * MiB, OFF_ZA = 446 * MiB, OFF_MEMO0 = 446 * MiB;
constexpr size_t OFF_X1B = 204 * MiB, OFF_Z1A = 60 * MiB, OFF_KN = 180 * MiB, OFF_MEMO1 = 204 * MiB, OFF_Z1B = 300 * MiB;
constexpr size_t WS_NEED = 512 * MiB;

struct Params {
  const float *x_prompt, *x_sample, *mem_prompt, *mem_sample, *norm_in, *w_out, *mem_norm, *w_mem_kv, *mem_q_norm, *mem_k_norm;
  const float *a_w_in, *a_q_a_norm, *a_w_q_b, *a_kv_a_norm, *a_w_kv_b, *a_q_norm, *a_k_norm, *b_w_in, *b_q_norm, *b_k_norm, *b_sink;
  float* out; char* ws;
};

extern __shared__ __attribute__((aligned(16))) char g_smem[];
constexpr int LDS_BYTES = 131072;

DEVI int crow(int r, int hi) { return (r & 3) + 8 * (r >> 2) + 4 * hi; }
DEVI unsigned cvtpk(float lo, float hi) { unsigned r; asm volatile("v_cvt_pk_bf16_f32 %0, %1, %2" : "=v"(r) : "v"(lo), "v"(hi)); return r; }
DEVI float bflo(unsigned w) { return __uint_as_float(w << 16); }
DEVI float bfhi(unsigned w) { return __uint_as_float(w & 0xffff0000u); }
DEVI float swap_sum(float v) { auto rr = __builtin_amdgcn_permlane32_swap(__float_as_uint(v), __float_as_uint(v), false, false); return __uint_as_float(rr[0]) + __uint_as_float(rr[1]); }
DEVI float swap_max(float v) { auto rr = __builtin_amdgcn_permlane32_swap(__float_as_uint(v), __float_as_uint(v), false, false); return fmaxf(__uint_as_float(rr[0]), __uint_as_float(rr[1])); }
#define PK4(P, BASE, OUT) do { unsigned a0_ = cvtpk(P[BASE + 0], P[BASE + 1]), a1_ = cvtpk(P[BASE + 2], P[BASE + 3]);   \
    unsigned b0_ = cvtpk(P[BASE + 4], P[BASE + 5]), b1_ = cvtpk(P[BASE + 6], P[BASE + 7]);                              \
    auto r0_ = __builtin_amdgcn_permlane32_swap(a0_, b0_, false, false); auto r1_ = __builtin_amdgcn_permlane32_swap(a1_, b1_, false, false); \
    u32x4 w_ = {r0_[0], r1_[0], r0_[1], r1_[1]}; OUT = __builtin_bit_cast(bf16x8, w_); } while (0)
DEVI const float* x_row(const Params& p, int tok) { return tok < NPROMPT_TOK ? p.x_prompt + (size_t)tok * 1024 : p.x_sample + (size_t)(tok - NPROMPT_TOK) * 1024; }
DEVI const float* mem_row(const Params& p, int r) { return r < NPROMPT_MEM ? p.mem_prompt + (size_t)r * 1024 : p.mem_sample + (size_t)(r - NPROMPT_MEM) * 1024; }
DEVI int remap_tile(int it) {
  const int G = gridDim.x, b = blockIdx.x;
  return (G & 7) ? it * G + b : it * G + (b & 7) * (G >> 3) + (b >> 3);
}

DEVI void wt_job(const float* __restrict__ W, const float* __restrict__ g, bf16* __restrict__ out, int K, int N, int Npad, long gt, long gsz) {
  const int nq = Npad >> 2; const long total = (long)nq * (K >> 3);
  for (long i = gt; i < total; i += gsz) {
    const int n4 = (int)(i % nq) << 2; const int k0 = (int)(i / nq) << 3;
    f32x4 v[8];
    if (n4 < N) {
#pragma unroll
      for (int j = 0; j < 8; ++j) { v[j] = *reinterpret_cast<const f32x4*>(W + (size_t)(k0 + j) * N + n4); const float gj = g ? g[k0 + j] : 1.f; v[j][0] *= gj; v[j][1] *= gj; v[j][2] *= gj; v[j][3] *= gj; }
    } else {
#pragma unroll
      for (int j = 0; j < 8; ++j) v[j] = f32x4{0.f, 0.f, 0.f, 0.f};
    }
#pragma unroll
    for (int c = 0; c < 4; ++c)
      *reinterpret_cast<u32x4*>(out + (size_t)(n4 + c) * K + k0) = u32x4{cvtpk(v[0][c], v[1][c]), cvtpk(v[2][c], v[3][c]), cvtpk(v[4][c], v[5][c]), cvtpk(v[6][c], v[7][c])};
  }
}
DEVI void row_job4(const Params& p, int r0, int lane) {
  char* ws = p.ws;
  f32x4 v[4][4];
#pragma unroll
  for (int k = 0; k < 4; ++k) { const int r = r0 + k;
    const float* src = r < NTOK ? x_row(p, r) : mem_row(p, r - NTOK);
#pragma unroll
    for (int i = 0; i < 2; ++i) { v[k][2 * i] = *reinterpret_cast<const f32x4*>(src + lane * 8 + 512 * i); v[k][2 * i + 1] = *reinterpret_cast<const f32x4*>(src + lane * 8 + 512 * i + 4); } }
#pragma unroll
  for (int k = 0; k < 4; ++k) { const int r = r0 + k;
    bf16* dst = r < NTOK ? (bf16*)(ws + OFF_XB) + (size_t)r * 1024 : (bf16*)(ws + OFF_MEMB) + (size_t)(r - NTOK) * 1024;
    float ss = 0.f;
#pragma unroll
    for (int i = 0; i < 2; ++i) { const f32x4 a = v[k][2 * i], c = v[k][2 * i + 1];
      ss += a[0] * a[0] + a[1] * a[1] + a[2] * a[2] + a[3] * a[3] + c[0] * c[0] + c[1] * c[1] + c[2] * c[2] + c[3] * c[3];
      *reinterpret_cast<u32x4*>(dst + lane * 8 + 512 * i) = u32x4{cvtpk(a[0], a[1]), cvtpk(a[2], a[3]), cvtpk(c[0], c[1]), cvtpk(c[2], c[3])}; }
#pragma unroll
    for (int o = 32; o > 0; o >>= 1) ss += __shfl_xor(ss, o, 64);
    if (lane == 0) { if (r < NTOK) ((float*)(ws + OFF_SS0))[r] = ss; else ((float*)(ws + OFF_SSM))[r - NTOK] = ss; }
  }
}
DEVI void phase_prep(const Params& p) {
  char* ws = p.ws; LAUNDER_TID(tid);
  const long gt = (long)blockIdx.x * 512 + tid, gsz = (long)gridDim.x * 512;
  wt_job(p.a_w_in, p.norm_in, (bf16*)(ws + OFF_WA), 1024, 2752, 2816, gt, gsz);
  wt_job(p.b_w_in, p.norm_in + 1024, (bf16*)(ws + OFF_WB), 1024, 3328, 3328, gt, gsz);
  wt_job(p.w_out, nullptr, (bf16*)(ws + OFF_WO), 1536, 1024, 1024, gt, gsz);
  wt_job(p.w_out + 1536 * 1024, nullptr, (bf16*)(ws + OFF_WO + WO_BYTES), 1536, 1024, 1024, gt, gsz);
  wt_job(p.w_mem_kv, p.mem_norm, (bf16*)(ws + OFF_WM), 1024, 1024, 1024, gt, gsz);
  wt_job(p.w_mem_kv + 1024 * 1024, p.mem_norm + 1024, (bf16*)(ws + OFF_WM + WM_BYTES), 1024, 1024, 1024, gt, gsz);
  wt_job(p.a_w_q_b, p.a_q_a_norm, (bf16*)(ws + OFF_WQ), 384, 1536, 1536, gt, gsz);
  wt_job(p.a_w_kv_b, p.a_kv_a_norm, (bf16*)(ws + OFF_WKV), 256, 2048, 2048, gt, gsz);
  float* rc = (float*)(ws + OFF_ROPE); float* rs = rc + 4096 * 32;
  for (long i = gt; i < 4096 * 32; i += gsz) {
    const int pos = (int)(i >> 5), f = (int)(i & 31);
    const float inv = exp2f(-(float)f * (13.287712379549449f / 32.f));
    float rev = (float)pos * inv * 0.15915494309189535f; rev -= floorf(rev);
    rc[i] = __builtin_amdgcn_cosf(rev); rs[i] = __builtin_amdgcn_sinf(rev);
  }
  float* ss1 = (float*)(ws + OFF_SS1);
  for (long i = gt; i < NTOK; i += gsz) ss1[i] = 0.f;
  const int wid = tid >> 6, lane = tid & 63;
  const int nw = gridDim.x * 8;
  for (int r = (blockIdx.x * 8 + wid) * 4; r < NTOK + NMEMROW; r += nw * 4) row_job4(p, r, lane);
}

enum { G_Z0 = 0, G_MKV0 = 1, G_MKV1 = 2, G_OUT0 = 3, G_Z1 = 4, G_OUT1 = 5 };
constexpr int BK = 64, HALF = 128, HT = HALF * BK;
DEVI int lds_byte(int r, int c) { int st = (r >> 4) * 2 + (c >> 5), rr = r & 15, cc = c & 31, ob = rr * 64 + cc * 2; return st * 1024 + (ob ^ (((ob >> 9) & 1) << 5)); }
DEVI void stage_rc(int b, int& R, int& C) { int st = b / 1024, sb = b % 1024, swz = sb ^ (((sb >> 9) & 1) << 5); R = (st >> 1) * 16 + swz / 64; C = (st & 1) * 32 + (swz % 64) / 2; }

template <int MODE> DEVI const bf16* a_ptr(const Params& p, int kt, int& lda) {
  char* ws = p.ws; const int k = kt * 64;
  if constexpr (MODE == G_Z0) { lda = 1024; return (const bf16*)(ws + OFF_XB) + k; }
  else if constexpr (MODE == G_MKV0 || MODE == G_MKV1) { lda = 1024; return (const bf16*)(ws + OFF_MEMB) + k; }
  else if constexpr (MODE == G_Z1) { lda = 1024; return (const bf16*)(ws + OFF_X1B) + k; }
  else if constexpr (MODE == G_OUT0) {
    if (k < 1024) { lda = 1536; return (const bf16*)(ws + OFF_Q0) + (k >> 7) * 192 + (k & 127); }
    lda = 512; return (const bf16*)(ws + OFF_MEMO0) + (k - 1024);
  } else {
    if (k < 1024) { lda = 1280; return (const bf16*)(ws + OFF_Z1A) + k; }
    lda = 512; return (const bf16*)(ws + OFF_MEMO1) + (k - 1024);
  }
}

template <int MODE>
DEVI void gemm_tile(const Params& p, int pm, int pn) {
  constexpr int K = (MODE == G_OUT0 || MODE == G_OUT1) ? 1536 : 1024;
  constexpr int nt = K / BK;
  char* ws = p.ws; LAUNDER_TID(tid);
  const bf16* Bt = (const bf16*)(ws + (MODE == G_Z0 ? OFF_WA : MODE == G_MKV0 ? OFF_WM : MODE == G_MKV1 ? OFF_WM + WM_BYTES : MODE == G_OUT0 ? OFF_WO : MODE == G_Z1 ? OFF_WB : OFF_WO + WO_BYTES));
  bf16* shm = (bf16*)g_smem;
  const int brow = pm * 256, bcol = pn * 256;
#define SA(b, h) (shm + ((b) * 2 + (h)) * HT)
#define SB(b, h) (shm + (4 + (b) * 2 + (h)) * HT)
#define STAGE_B(P, half, kt) do { const bf16* _g = Bt + (size_t)(bcol + (half) * HALF) * K + (size_t)(kt) * BK;              \
    _Pragma("unroll") for (int _i = 0; _i < 2; ++_i)                                                                          \
      __builtin_amdgcn_global_load_lds((const unsigned*)(_g + ((st_rc[_i] & 255) * K + (st_rc[_i] >> 8))), (unsigned*)((char*)(P) + tid * 16 + _i * 8192), 16, 0, 0); } while (0)
#define STAGE_A(P, half, kt) do { int _lda; const bf16* _g = a_ptr<MODE>(p, (kt), _lda) + (size_t)(brow + (half) * HALF) * _lda; \
    _Pragma("unroll") for (int _i = 0; _i < 2; ++_i)                                                                          \
      __builtin_amdgcn_global_load_lds((const unsigned*)(_g + ((st_rc[_i] & 255) * _lda + (st_rc[_i] >> 8))), (unsigned*)((char*)(P) + tid * 16 + _i * 8192), 16, 0, 0); } while (0)
#define LDA(dst, b, h) for (int m = 0; m < 4; ++m) for (int k = 0; k < 2; ++k) \
    dst[m][k] = *reinterpret_cast<const bf16x8*>((char*)SA(b, h) + lds_byte(wr * 64 + m * 16 + fr, k * 32 + fq * 8))
#define LDB(dst, b, h) for (int n = 0; n < 2; ++n) for (int k = 0; k < 2; ++k) \
    dst[n][k] = *reinterpret_cast<const bf16x8*>((char*)SB(b, h) + lds_byte(wc * 32 + n * 16 + fr, k * 32 + fq * 8))
#define MMA(ai, bj, At_, Bt_) do { __builtin_amdgcn_s_setprio(1); \
    for (int m = 0; m < 4; ++m) for (int n = 0; n < 2; ++n) for (int k = 0; k < 2; ++k) \
      acc[ai][bj][m][n] = __builtin_amdgcn_mfma_f32_16x16x32_bf16(Bt_[n][k], At_[m][k], acc[ai][bj][m][n], 0, 0, 0); \
    __builtin_amdgcn_s_setprio(0); } while (0)
#define WAIT_V(n) asm volatile("s_waitcnt vmcnt(" #n ")" ::: "memory")
#define WAIT_L(n) asm volatile("s_waitcnt lgkmcnt(" #n ")" ::: "memory")
#define BAR __builtin_amdgcn_s_barrier()
  const int wid = tid >> 6, lane = tid & 63, wr = wid >> 2, wc = wid & 3, fr = lane & 15, fq = lane >> 4;
  f32x4 acc[2][2][4][2] = {};
  bf16x8 At[4][2], B0[2][2], B1[2][2];
  int st_rc[2];
#pragma unroll
  for (int i = 0; i < 2; ++i) { int r_, c_; stage_rc(tid * 16 + i * 8192, r_, c_); st_rc[i] = r_ | (c_ << 8); }
  __syncthreads();
  STAGE_B(SB(0, 0), 0, 0); STAGE_A(SA(0, 0), 0, 0);
  STAGE_B(SB(0, 1), 1, 0); STAGE_A(SA(0, 1), 1, 0);
  if (wr == 1) BAR;
  WAIT_V(4); BAR;
  STAGE_B(SB(1, 0), 0, 1); STAGE_A(SA(1, 0), 0, 1); STAGE_B(SB(1, 1), 1, 1);
  WAIT_V(6); BAR;
  for (int t = 0; t < nt - 2; t += 2) {
    LDB(B0, 0, 0); SBAR(); LDA(At, 0, 0); STAGE_A(SA(1, 1), 1, t + 1);
    WAIT_L(8); BAR; WAIT_L(0); MMA(0, 0, At, B0); BAR; SBAR();
    LDB(B1, 0, 1); STAGE_B(SB(0, 0), 0, t + 2);
    BAR; WAIT_L(0); MMA(0, 1, At, B1); BAR;
    LDA(At, 0, 1); STAGE_A(SA(0, 0), 0, t + 2);
    BAR; WAIT_L(0); MMA(1, 0, At, B0); BAR; SBAR();
    STAGE_B(SB(0, 1), 1, t + 2);
    WAIT_V(6); BAR; MMA(1, 1, At, B1); BAR;
    LDB(B0, 1, 0); SBAR(); LDA(At, 1, 0); STAGE_A(SA(0, 1), 1, t + 2);
    WAIT_L(8); BAR; WAIT_L(0); MMA(0, 0, At, B0); BAR; SBAR();
    LDB(B1, 1, 1); STAGE_B(SB(1, 0), 0, t + 3);
    BAR; WAIT_L(0); MMA(0, 1, At, B1); BAR;
    LDA(At, 1, 1); STAGE_A(SA(1, 0), 0, t + 3);
    BAR; WAIT_L(0); MMA(1, 0, At, B0); BAR; SBAR();
    STAGE_B(SB(1, 1), 1, t + 3);
    WAIT_V(6); BAR; MMA(1, 1, At, B1); BAR;
  }
  { LDB(B0, 0, 0); LDA(At, 0, 0); STAGE_A(SA(1, 1), 1, nt - 1);
    BAR; WAIT_L(0); MMA(0, 0, At, B0); BAR;
    LDB(B1, 0, 1); BAR; WAIT_L(0); MMA(0, 1, At, B1); BAR;
    LDA(At, 0, 1); WAIT_V(4); BAR; WAIT_L(0); MMA(1, 0, At, B0); MMA(1, 1, At, B1); BAR; }
  { LDB(B0, 1, 0); LDA(At, 1, 0); WAIT_V(2); BAR; WAIT_L(0); MMA(0, 0, At, B0); BAR;
    LDB(B1, 1, 1); WAIT_V(0); BAR; WAIT_L(0); MMA(0, 1, At, B1); BAR;
    LDA(At, 1, 1); BAR; WAIT_L(0); MMA(1, 0, At, B0); MMA(1, 1, At, B1); BAR; }
  if (wr == 0) BAR;
#undef SA
#undef SB
#undef STAGE_A
#undef STAGE_B
#undef LDA
#undef LDB
#undef MMA
  float rs8[2][4];
  if constexpr (MODE == G_Z0 || MODE == G_Z1 || MODE == G_MKV0 || MODE == G_MKV1) {
    const float* ssp = (const float*)(ws + (MODE == G_Z0 ? OFF_SS0 : MODE == G_Z1 ? OFF_SS1 : OFF_SSM));
#pragma unroll
    for (int ai = 0; ai < 2; ++ai)
#pragma unroll
      for (int m = 0; m < 4; ++m) rs8[ai][m] = ssp[brow + ai * HALF + wr * 64 + m * 16 + fr];
#pragma unroll
    for (int ai = 0; ai < 2; ++ai)
#pragma unroll
      for (int m = 0; m < 4; ++m) rs8[ai][m] = rsqrtf(rs8[ai][m] * (1.f / 1024.f) + EPS);
  }
#pragma unroll
  for (int ai = 0; ai < 2; ++ai) {
    f32x4 resv[4][4];
    if constexpr (MODE == G_OUT0 || MODE == G_OUT1) {
#pragma unroll
      for (int m = 0; m < 4; ++m) { const int row = brow + ai * HALF + wr * 64 + m * 16 + fr;
        const float* res = (MODE == G_OUT0) ? x_row(p, row) : p.out + (size_t)row * 1024;
#pragma unroll
        for (int bj = 0; bj < 2; ++bj)
#pragma unroll
          for (int n = 0; n < 2; ++n) resv[m][bj * 2 + n] = *reinterpret_cast<const f32x4*>(res + bcol + bj * HALF + wc * 32 + n * 16 + fq * 4); }
    }
#pragma unroll
    for (int m = 0; m < 4; ++m) {
      const int row = brow + ai * HALF + wr * 64 + m * 16 + fr;
      if constexpr (MODE == G_Z0 || MODE == G_Z1 || MODE == G_MKV0 || MODE == G_MKV1) {
        const float rs = rs8[ai][m];
#pragma unroll
        for (int bj = 0; bj < 2; ++bj) {
          const f32x4 a0 = acc[ai][bj][m][0], a1 = acc[ai][bj][m][1];
          const unsigned x0 = cvtpk(a0[0] * rs, a0[1] * rs), x1 = cvtpk(a0[2] * rs, a0[3] * rs);
          const unsigned y0 = cvtpk(a1[0] * rs, a1[1] * rs), y1 = cvtpk(a1[2] * rs, a1[3] * rs);
          const auto s0 = __builtin_amdgcn_permlane16_swap(x0, y0, false, false), s1 = __builtin_amdgcn_permlane16_swap(x1, y1, false, false);
          const u32x4 w = {s0[0], s1[0], s0[1], s1[1]};
          const int col = bcol + bj * HALF + wc * 32 + (fq & 1) * 16 + (fq >> 1) * 8;
          if constexpr (MODE == G_Z0) {
            if (col < 704) *reinterpret_cast<u32x4*>((bf16*)(ws + OFF_ZA) + (size_t)row * 704 + col) = w;
            else if (col < 2752) *reinterpret_cast<u32x4*>((bf16*)p.out + (size_t)row * 2048 + (col - 704)) = w;
          } else if constexpr (MODE == G_Z1) {
            if (col < 1280) *reinterpret_cast<u32x4*>((bf16*)(ws + OFF_Z1A) + (size_t)row * 1280 + col) = w;
            else *reinterpret_cast<u32x4*>((bf16*)(ws + OFF_Z1B) + (size_t)row * 2048 + (col - 1280)) = w;
          } else {
            *reinterpret_cast<u32x4*>((bf16*)(ws + OFF_MEMKV + (MODE == G_MKV1 ? MEMKV_BYTES : 0)) + (size_t)row * 1024 + col) = w;
          }
        }
      } else {
        float* dst = p.out + (size_t)row * 1024;
        float ssl = 0.f;
#pragma unroll
        for (int bj = 0; bj < 2; ++bj)
#pragma unroll
          for (int n = 0; n < 2; ++n) {
            const int col = bcol + bj * HALF + wc * 32 + n * 16 + fq * 4;
            const f32x4 a = acc[ai][bj][m][n];
            f32x4 x = resv[m][bj * 2 + n];
            x[0] += a[0]; x[1] += a[1]; x[2] += a[2]; x[3] += a[3];
            *reinterpret_cast<f32x4*>(dst + col) = x;
            if constexpr (MODE == G_OUT0) {
              ssl += x[0] * x[0] + x[1] * x[1] + x[2] * x[2] + x[3] * x[3];
              *reinterpret_cast<u32x2*>((bf16*)(ws + OFF_X1B) + (size_t)row * 1024 + col) = u32x2{cvtpk(x[0], x[1]), cvtpk(x[2], x[3])};
            }
          }
        if constexpr (MODE == G_OUT0) {
          ssl += __shfl_xor(ssl, 16, 64); ssl += __shfl_xor(ssl, 32, 64);
          if (fq == 0) atomicAdd((float*)(ws + OFF_SS1) + row, ssl);
        }
      }
    }
  }
}

template <int MODE> DEVI void gemm_tiles_grouped(const Params& p, int t, int nM, int nN) {
  constexpr int WGM = 8;
  const int nig = WGM * nN, gid = t / nig, fm = gid * WGM, gsz = min(nM - fm, WGM);
  const int pm = fm + ((t % nig) % gsz), pn = (t % nig) / gsz;
  gemm_tile<MODE>(p, pm, pn);
}

DEVI void phase_gemm1(const Params& p) {
  constexpr int NZ = 192 * 11, NT = NZ + 2 * 48;
  for (int it = 0;; ++it) {
    const int t = remap_tile(it); if (it * (int)gridDim.x >= NT) break; if (t >= NT) continue;
    if (t < NZ) gemm_tiles_grouped<G_Z0>(p, t, 192, 11);
    else { const int u = t - NZ; if (u < 48) gemm_tile<G_MKV0>(p, u % 12, u / 12); else gemm_tile<G_MKV1>(p, (u - 48) % 12, (u - 48) / 12); }
  }
}
template <int MODE> DEVI void phase_gemm_simple(const Params& p, int nN) {
  const int NT = 192 * nN;
  for (int it = 0;; ++it) {
    const int t = remap_tile(it); if (it * (int)gridDim.x >= NT) break; if (t >= NT) continue;
    gemm_tiles_grouped<MODE>(p, t, 192, nN);
  }
}

DEVI int swz128(int row, int ch) { return row * 128 + ((ch ^ ((row >> 1) & 7)) << 4); }

template <int KDIM, int NB>
DEVI void small_gemm(const bf16* __restrict__ A  , int lda, const bf16* __restrict__ W  ,
                     f32x16 (&acc)[NB], float& ssrow, int tid) {
  constexpr int NC = KDIM / 64, WPT = NB * 32 * 8 / 512;
  const int wid = tid >> 6, lane = tid & 63, r32 = lane & 31, hi = lane >> 5;
  char* lds = g_smem;
  int aoff[4], woff[WPT];
#pragma unroll
  for (int i_ = 0; i_ < 4; ++i_) { const int q_ = tid + 512 * i_, row_ = q_ >> 3, ch_ = (q_ & 7) ^ ((row_ >> 1) & 7); aoff[i_] = row_ * lda + ch_ * 8; }
#pragma unroll
  for (int i_ = 0; i_ < WPT; ++i_) { const int q_ = tid + 512 * i_, row_ = q_ >> 3, ch_ = (q_ & 7) ^ ((row_ >> 1) & 7); woff[i_] = row_ * KDIM + ch_ * 8; }
#define SG_LOAD(b, c) do { const bf16* ag_ = A + (c) * 64; const bf16* wg_ = W + (c) * 64;                                     \
    _Pragma("unroll") for (int i_ = 0; i_ < 4; ++i_)                                                                           \
      __builtin_amdgcn_global_load_lds((const unsigned*)(ag_ + aoff[i_]), (unsigned*)(lds + (b) * 32768 + (tid + 512 * i_) * 16), 16, 0, 0); \
    _Pragma("unroll") for (int i_ = 0; i_ < WPT; ++i_)                                                                         \
      __builtin_amdgcn_global_load_lds((const unsigned*)(wg_ + woff[i_]), (unsigned*)(lds + 65536 + (b) * 32768 + (tid + 512 * i_) * 16), 16, 0, 0); } while (0)
#pragma unroll
  for (int nb = 0; nb < NB; ++nb) acc[nb] = f32x16{};
  float ss = 0.f;
  __syncthreads();
  SG_LOAD(0, 0); asm volatile("s_waitcnt vmcnt(0)" ::: "memory"); __syncthreads();
#pragma unroll 1
  for (int c = 0; c < NC; ++c) {
    const int b = c & 1;
    if (c + 1 < NC) SG_LOAD(b ^ 1, c + 1);
#pragma unroll
    for (int ks = 0; ks < 4; ++ks) {
      const int ch = ks * 2 + hi;
      const bf16x8 a = *reinterpret_cast<const bf16x8*>(lds + b * 32768 + swz128(wid * 32 + r32, ch));
      const u32x4 au = __builtin_bit_cast(u32x4, a);
#pragma unroll
      for (int j = 0; j < 4; ++j) { const float lo = bflo(au[j]), h2 = bfhi(au[j]); ss += lo * lo + h2 * h2; }
#pragma unroll
      for (int nb = 0; nb < NB; ++nb) {
        const bf16x8 w = *reinterpret_cast<const bf16x8*>(lds + 65536 + b * 32768 + swz128(nb * 32 + r32, ch));
        acc[nb] = __builtin_amdgcn_mfma_f32_32x32x16_bf16(w, a, acc[nb], 0, 0, 0);
      }
      SBAR();
    }
    asm volatile("s_waitcnt vmcnt(0)" ::: "memory"); __syncthreads();
  }
  ssrow = swap_sum(ss);
#undef SG_LOAD
}

DEVI void rope_pair(f32x16& x1, f32x16& x2, const float* __restrict__ rc, const float* __restrict__ rs, int pos, int hi) {
#pragma unroll
  for (int g = 0; g < 4; ++g) {
    const f32x4 c = *reinterpret_cast<const f32x4*>(rc + pos * 32 + 8 * g + 4 * hi);
    const f32x4 s = *reinterpret_cast<const f32x4*>(rs + pos * 32 + 8 * g + 4 * hi);
#pragma unroll
    for (int j = 0; j < 4; ++j) { const float a = x1[4 * g + j], b = x2[4 * g + j]; x1[4 * g + j] = a * c[j] - b * s[j]; x2[4 * g + j] = b * c[j] + a * s[j]; }
  }
}
DEVI void store_blk(bf16* __restrict__ dst  , const f32x16& v, int hi) {
  bf16x8 o0, o1; PK4(v, 0, o0); PK4(v, 8, o1);
  *reinterpret_cast<bf16x8*>(dst + hi * 8) = o0; *reinterpret_cast<bf16x8*>(dst + 16 + hi * 8) = o1;
}

DEVI void scale_gain_blk(f32x16& v, const f32x16& a, float f, const float* __restrict__ gain  , int hi) {
#pragma unroll
  for (int g = 0; g < 4; ++g) {
    const f32x4 gn = *reinterpret_cast<const f32x4*>(gain + 8 * g + 4 * hi);
#pragma unroll
    for (int j = 0; j < 4; ++j) v[4 * g + j] = a[4 * g + j] * (f * gn[j]);
  }
}
DEVI void gain_inplace(f32x16& v, float f, const float* __restrict__ gain, int hi) {
  float gs[32];
  cfloat_p cg = (cfloat_p)(uintptr_t)gain;
#pragma unroll
  for (int i = 0; i < 32; ++i) gs[i] = cg[i];
#pragma unroll
  for (int g = 0; g < 4; ++g)
#pragma unroll
    for (int j = 0; j < 4; ++j) v[4 * g + j] *= f * (hi ? gs[8 * g + 4 + j] : gs[8 * g + j]);
}
DEVI void rope_cs(int pos, int i, float& c, float& s) {
  const float inv = __builtin_amdgcn_exp2f(-(float)i * (13.287712379549449f / 32.f)) * 0.15915494309189535f;
  float rev = (float)pos * inv; rev -= floorf(rev);
  c = __builtin_amdgcn_cosf(rev); s = __builtin_amdgcn_sinf(rev);
}
DEVI void rope_inplace(f32x16& x1, f32x16& x2, int pos, int hi) {
#pragma unroll
  for (int g = 0; g < 4; ++g)
#pragma unroll
    for (int j = 0; j < 4; ++j) { float c, s; rope_cs(pos, 8 * g + 4 * hi + j, c, s);
      const float a = x1[4 * g + j], b = x2[4 * g + j]; x1[4 * g + j] = a * c - b * s; x2[4 * g + j] = b * c + a * s; }
}
DEVI void p2_epi_q(const Params& p, f32x16 (&acc)[6], float rs, int tok, int h, int hi) {
  char* ws = p.ws; LAUNDER_PTR(ws);
  float hs = 0.f;
#pragma unroll
  for (int nb = 0; nb < 6; ++nb)
#pragma unroll
    for (int r = 0; r < 16; ++r) hs += acc[nb][r] * acc[nb][r];
  hs = swap_sum(hs) * rs * rs;
  const float f = rs * rsqrtf(hs * (1.f / 192.f) + EPS) * (0.07216878364870322f * LOG2E);
  const int pos = tok & (SEQ - 1);
  bf16* dst = (bf16*)(ws + OFF_Q0) + (size_t)tok * 1536 + h * 192;
  SBAR();
  gain_inplace(acc[4], f, p.a_q_norm + 128, hi); gain_inplace(acc[5], f, p.a_q_norm + 160, hi);
  rope_inplace(acc[4], acc[5], pos, hi);
  store_blk(dst + 128, acc[4], hi); SBAR(); store_blk(dst + 160, acc[5], hi); SBAR();
#pragma unroll
  for (int nb = 0; nb < 4; ++nb) { gain_inplace(acc[nb], f, p.a_q_norm + nb * 32, hi); store_blk(dst + nb * 32, acc[nb], hi); SBAR(); }
}
DEVI void p2_epi_k(const Params& p, f32x16 (&acc)[4], float rs, int tok, int h, int hi) {
  char* ws = p.ws; LAUNDER_PTR(ws);
  const int pos = tok & (SEQ - 1);
  float ks = 0.f, kq = 0.f;
#pragma unroll
  for (int nb = 0; nb < 4; ++nb)
#pragma unroll
    for (int r = 0; r < 16; ++r) ks += acc[nb][r] * acc[nb][r];
  SBAR();
  const bf16* kr = (const bf16*)(ws + OFF_ZA) + (size_t)tok * 704 + 640;
#pragma unroll
  for (int g = 0; g < 4; ++g) {
    const u32x2 a = *reinterpret_cast<const u32x2*>(kr + 8 * g + 4 * hi), b = *reinterpret_cast<const u32x2*>(kr + 32 + 8 * g + 4 * hi);
    kq += bflo(a[0]) * bflo(a[0]) + bfhi(a[0]) * bfhi(a[0]) + bflo(a[1]) * bflo(a[1]) + bfhi(a[1]) * bfhi(a[1]);
    kq += bflo(b[0]) * bflo(b[0]) + bfhi(b[0]) * bfhi(b[0]) + bflo(b[1]) * bflo(b[1]) + bfhi(b[1]) * bfhi(b[1]);
  }
  ks = swap_sum(ks * rs * rs + kq);
  const float rk = rsqrtf(ks * (1.f / 192.f) + EPS);
  bf16* kd = (bf16*)(ws + OFF_K0) + (size_t)tok * 1536 + h * 192;
  SBAR();
  float g1s[32], g2s[32];
  { cfloat_p ck = (cfloat_p)(uintptr_t)p.a_k_norm;
#pragma unroll
    for (int i = 0; i < 32; ++i) { g1s[i] = ck[128 + i]; g2s[i] = ck[160 + i]; } }
#pragma unroll
  for (int hf = 0; hf < 2; ++hf) {
    float x1[8], x2[8];
#pragma unroll
    for (int gg = 0; gg < 2; ++gg) {
      const int g = 2 * hf + gg;
      const u32x2 a = *reinterpret_cast<const u32x2*>(kr + 8 * g + 4 * hi), b = *reinterpret_cast<const u32x2*>(kr + 32 + 8 * g + 4 * hi);
      const float av[4] = {bflo(a[0]), bfhi(a[0]), bflo(a[1]), bfhi(a[1])}, bv[4] = {bflo(b[0]), bfhi(b[0]), bflo(b[1]), bfhi(b[1])};
#pragma unroll
      for (int j = 0; j < 4; ++j) { float c, sn; rope_cs(pos, 8 * g + 4 * hi + j, c, sn);
        const float u = av[j] * rk * (hi ? g1s[8 * g + 4 + j] : g1s[8 * g + j]), w = bv[j] * rk * (hi ? g2s[8 * g + 4 + j] : g2s[8 * g + j]);
        x1[4 * gg + j] = u * c - w * sn; x2[4 * gg + j] = w * c + u * sn; }
    }
    bf16x8 o1, o2; PK4(x1, 0, o1); PK4(x2, 0, o2);
    *reinterpret_cast<bf16x8*>(kd + 128 + hf * 16 + hi * 8) = o1; *reinterpret_cast<bf16x8*>(kd + 160 + hf * 16 + hi * 8) = o2;
  }
#pragma unroll
  for (int nb = 0; nb < 4; ++nb) { gain_inplace(acc[nb], rs * rk, p.a_k_norm + nb * 32, hi); store_blk(kd + nb * 32, acc[nb], hi); SBAR(); }
}
DEVI void p2_epi_v(const Params& p, f32x16 (&acc)[4], float rs, int tok, int h, int hi) {
  char* ws = p.ws; LAUNDER_PTR(ws);
  bf16* vd = (bf16*)(ws + OFF_V0) + (size_t)tok * 1024 + h * 128;
#pragma unroll
  for (int nb = 0; nb < 4; ++nb) {
#pragma unroll
    for (int r = 0; r < 16; ++r) acc[nb][r] *= rs;
    store_blk(vd + nb * 32, acc[nb], hi); SBAR();
  }
}

template <bool ISQ>
DEVI void p2_job(const Params& p, int mt, int half) {
  constexpr int KDIM = ISQ ? 384 : 256, NFR = KDIM / 16, NB = ISQ ? 6 : 4, NC = KDIM / 64, NPART = ISQ ? 4 : 8;
  constexpr int ROWS = NB * 32, LPC = ROWS * 8 / 512, STG = ROWS * 128, NSTG = ISQ ? 4 : 5, DEPTH = NSTG - 1;
  constexpr int NFH = ISQ ? NFR - 4 : NFR;
  char* ws = p.ws; LAUNDER_PTR(ws); char* lds = g_smem;
  LAUNDER_TID(tid); const int wid = tid >> 6, lane = tid & 63, r32 = lane & 31, hi = lane >> 5;
  const int tok = mt * 256 + wid * 32 + r32;
  const bf16* Wb = ISQ ? (const bf16*)(ws + OFF_WQ) + (size_t)(half * 4) * 192 * 384 : (const bf16*)(ws + OFF_WKV) + (size_t)(half * 4) * 256 * 256;
  int ip = 0, ic = 0, si = 0;
#define P2_ISSUE() do { const bf16* wg_ = Wb + (size_t)ip * (ROWS * KDIM) + ic * 64; const unsigned woff0 = (tid >> 3) * KDIM + (((tid & 7) ^ ((tid >> 4) & 7)) * 8); \
    _Pragma("unroll") for (int i_ = 0; i_ < LPC; ++i_)                                                                          \
      __builtin_amdgcn_global_load_lds((const unsigned*)((wg_ + i_ * 64 * KDIM) + woff0), (unsigned*)(lds + si * STG + (tid + 512 * i_) * 16), 16, 0, 0); \
    si = (si == NSTG - 1) ? 0 : si + 1;                                                                                         \
    if (!(ip == NPART - 1 && ic == NC - 1)) { if (++ic == NC) { ic = 0; ++ip; } } } while (0)
  const bf16* arow = (const bf16*)(ws + OFF_ZA) + (size_t)tok * 704 + (ISQ ? 0 : 384) + hi * 8;
  float ss = 0.f;
#pragma unroll
  for (int f = 0; f < NFR; ++f) { const u32x4 au = *reinterpret_cast<const u32x4*>(arow + f * 16);
#pragma unroll
    for (int j = 0; j < 4; ++j) { const float lo = bflo(au[j]), h2 = bfhi(au[j]); ss += lo * lo + h2 * h2; } }
  const float rs = rsqrtf(swap_sum(ss) * (1.f / KDIM) + EPS);
  asm volatile("" ::: "memory"); SBAR();
  __syncthreads();
  P2_ISSUE(); P2_ISSUE(); P2_ISSUE(); if constexpr (DEPTH == 4) P2_ISSUE();
  SBAR();
  bf16x8 af[NFH];
#pragma unroll
  for (int f = 0; f < NFH; ++f) af[f] = *reinterpret_cast<const bf16x8*>(arow + f * 16);
  char* apark = lds + NSTG * STG + wid * 4096 + lane * 16;
  if constexpr (ISQ) {
#pragma unroll
    for (int f = 0; f < 4; ++f) { const bf16x8 t = *reinterpret_cast<const bf16x8*>(arow + (NFH + f) * 16); *reinterpret_cast<bf16x8*>(apark + f * 1024) = t; }
  }
  asm volatile("s_waitcnt vmcnt(0)" ::: "memory");
  int sc = 0;
#define P2_PART() do {                                                                                                           \
    _Pragma("unroll") for (int nb = 0; nb < NB; ++nb) acc[nb] = f32x16{};                                                       \
    _Pragma("unroll") for (int c = 0; c < NC; ++c) {                                                                            \
      if (c >= DEPTH) asm volatile("s_waitcnt vmcnt(%0)" :: "n"((DEPTH - 1) * LPC) : "memory");                                  \
      __builtin_amdgcn_s_barrier();                                                                                              \
      P2_ISSUE();                                                                                                                \
      const char* wl = lds + sc * STG;                                                                                           \
      _Pragma("unroll") for (int ks = 0; ks < 4; ++ks) {                                                                        \
        const int ch = ks * 2 + hi; bf16x8 afl = {};                                                                             \
        if (c * 4 + ks >= NFH) afl = *reinterpret_cast<const bf16x8*>(apark + (c * 4 + ks - NFH) * 1024);                        \
        _Pragma("unroll") for (int nb = 0; nb < NB; ++nb) {                                                                     \
          const bf16x8 w = *reinterpret_cast<const bf16x8*>(wl + swz128(nb * 32 + r32, ch));                                     \
          acc[nb] = __builtin_amdgcn_mfma_f32_32x32x16_bf16(w, (c * 4 + ks < NFH) ? af[(c * 4 + ks < NFH) ? c * 4 + ks : 0] : afl, acc[nb], 0, 0, 0); \
          if (NB == 6 && nb == 2) SBAR();                                                                                        \
        }                                                                                                                        \
        SBAR();                                                                                                                  \
      }                                                                                                                          \
      sc = (sc == NSTG - 1) ? 0 : sc + 1;                                                                                        \
    } } while (0)
#pragma unroll 1
  for (int pi = 0; pi < NPART; ++pi) {
    f32x16 acc[NB];
    P2_PART();
    asm volatile("s_waitcnt vmcnt(0)" ::: "memory");
    { LAUNDER_TID(t2); const int tok2 = mt * 256 + (t2 >> 6) * 32 + (t2 & 31), hi2 = (t2 >> 5) & 1;
      if constexpr (ISQ) p2_epi_q(p, acc, rs, tok2, half * 4 + pi, hi2);
      else { if (pi & 1) p2_epi_v(p, acc, rs, tok2, half * 4 + (pi >> 1), hi2); else p2_epi_k(p, acc, rs, tok2, half * 4 + (pi >> 1), hi2); } }
  }
  asm volatile("s_waitcnt vmcnt(0)" ::: "memory");
#undef P2_PART
#undef P2_ISSUE
}

DEVI void phase_p2(const Params& p) {
  constexpr int NJ = 768;
  for (int it = 0;; ++it) {
    const int t = remap_tile(it); if (it * (int)gridDim.x >= NJ) break; if (t >= NJ) continue;
    const int mt = t >> 2, sub = t & 3;
    if (sub < 2) p2_job<true>(p, mt, sub); else p2_job<false>(p, mt, sub - 2);
  }
  char* ws = p.ws; LAUNDER_TID(tid);
  const int wid = tid >> 6, lane = tid & 63, nw = gridDim.x * 8;
  for (int r = blockIdx.x * 8 + wid; r < 2 * NMEMROW; r += nw) {
    const int l = r / NMEMROW, row = r % NMEMROW;
    bf16* kp = (bf16*)(ws + OFF_MEMKV + (size_t)l * MEMKV_BYTES) + (size_t)row * 1024;
    const float* gn = p.mem_k_norm + l * 128;
    {
      const int col = lane * 8;
      const u32x4 w = *reinterpret_cast<const u32x4*>(kp + col);
      float v[8]; float ss = 0.f;
#pragma unroll
      for (int j = 0; j < 4; ++j) { v[2 * j] = bflo(w[j]); v[2 * j + 1] = bfhi(w[j]); ss += v[2 * j] * v[2 * j] + v[2 * j + 1] * v[2 * j + 1]; }
      ss += __shfl_xor(ss, 1, 64); ss += __shfl_xor(ss, 2, 64); ss += __shfl_xor(ss, 4, 64); ss += __shfl_xor(ss, 8, 64);
      const float rr = rsqrtf(ss * (1.f / 128.f) + EPS);
      const int d = col & 127;
#pragma unroll
      for (int j = 0; j < 8; ++j) v[j] *= rr * gn[d + j];
      *reinterpret_cast<u32x4*>(kp + col) = u32x4{cvtpk(v[0], v[1]), cvtpk(v[2], v[3]), cvtpk(v[4], v[5]), cvtpk(v[6], v[7])};
    }
  }
}

constexpr int KVBLK = 64;
constexpr float THR = 8.f;
template <int DQK> DEVI int kswz(int row, int colB) {
  if constexpr (DQK == 128) return row * 256 + (colB ^ ((row & 7) << 4));
  else return row * 384 + (colB ^ (((row >> 1) & 7) << 4));
}
DEVI int v_st(int k, int c) { const int kk = (k & ~0xC) | ((k & 4) << 1) | ((k & 8) >> 1); return ((kk >> 3) * 4 + (c >> 5)) * 512 + ((kk & 7) * 32 + (c & 31)) * 2; }
DEVI int v_rd_base(int lane) { return ((lane & 3) << 3) | (((lane >> 2) & 3) << 6) | (((lane >> 4) & 1) << 5) | (((lane >> 5) & 1) << 8); }
constexpr int v_rd_off(int d0, int ks, int half) { return d0 * 512 + ks * 4096 + half * 2048; }
template <int OFF> DEVI s16x4 tr_read(int vb) { s16x4 r; asm volatile("ds_read_b64_tr_b16 %0, %1 offset:%2" : "=&v"(r) : "v"(vb), "i"(OFF) : "memory"); return r; }
template <int D0> DEVI void pv_one(f32x16& od, int vb, bf16x8 pa0, bf16x8 pa1, bf16x8 pa2, bf16x8 pa3) {
  const s16x4 l0 = tr_read<v_rd_off(D0, 0, 0)>(vb), h0 = tr_read<v_rd_off(D0, 0, 1)>(vb), l1 = tr_read<v_rd_off(D0, 1, 0)>(vb), h1 = tr_read<v_rd_off(D0, 1, 1)>(vb);
  const s16x4 l2 = tr_read<v_rd_off(D0, 2, 0)>(vb), h2 = tr_read<v_rd_off(D0, 2, 1)>(vb), l3 = tr_read<v_rd_off(D0, 3, 0)>(vb), h3 = tr_read<v_rd_off(D0, 3, 1)>(vb);
  asm volatile("s_waitcnt lgkmcnt(0)" ::: "memory"); SBAR();
#define PKV(L, H) (bf16x8){L[0], L[1], L[2], L[3], H[0], H[1], H[2], H[3]}
  od = __builtin_amdgcn_mfma_f32_32x32x16_bf16(pa0, PKV(l0, h0), od, 0, 0, 0);
  od = __builtin_amdgcn_mfma_f32_32x32x16_bf16(pa1, PKV(l1, h1), od, 0, 0, 0);
  od = __builtin_amdgcn_mfma_f32_32x32x16_bf16(pa2, PKV(l2, h2), od, 0, 0, 0);
  od = __builtin_amdgcn_mfma_f32_32x32x16_bf16(pa3, PKV(l3, h3), od, 0, 0, 0);
#undef PKV
}
DEVI void pv_d0(f32x16* o, int vb, bf16x8 pa0, bf16x8 pa1, bf16x8 pa2, bf16x8 pa3) {
  pv_one<0>(o[0], vb, pa0, pa1, pa2, pa3); pv_one<1>(o[1], vb, pa0, pa1, pa2, pa3); pv_one<2>(o[2], vb, pa0, pa1, pa2, pa3); pv_one<3>(o[3], vb, pa0, pa1, pa2, pa3);
}
template <int DQK> DEVI void partialSM(f32x16& p0, f32x16& p1, float& m_reg, float& mn, float& alpha) {
  constexpr float SCALE = (DQK == 192) ? 0.07216878364870322f : 0.08838834764831845f;
  constexpr float C = SCALE * LOG2E;
  float pmax = p0[0];
#pragma unroll
  for (int r = 1; r < 16; ++r) pmax = fmaxf(pmax, p0[r]);
#pragma unroll
  for (int r = 0; r < 16; ++r) pmax = fmaxf(pmax, p1[r]);
  pmax = swap_max(pmax);
  if (__builtin_expect(__all(pmax - m_reg <= THR / SCALE), 1)) { mn = m_reg; alpha = 1.f; }
  else { mn = fmaxf(m_reg, pmax); alpha = __builtin_amdgcn_exp2f((m_reg - mn) * C); m_reg = mn; }
  const float mnC = -mn * C;
#pragma unroll
  for (int r = 0; r < 16; ++r) p0[r] = fmaf(p0[r], C, mnC);
#pragma unroll
  for (int r = 0; r < 16; ++r) p1[r] = fmaf(p1[r], C, mnC);
#pragma unroll
  for (int r = 0; r < 16; ++r) p0[r] = __builtin_amdgcn_exp2f(p0[r]);
}
DEVI void finishSM(f32x16& p0, f32x16& p1, float alpha, float& l_reg, bf16x8& pa0, bf16x8& pa1, bf16x8& pa2, bf16x8& pa3) {
#pragma unroll
  for (int r = 0; r < 16; ++r) p1[r] = __builtin_amdgcn_exp2f(p1[r]);
  float ps = 0;
#pragma unroll
  for (int r = 0; r < 16; ++r) ps += p0[r];
#pragma unroll
  for (int r = 0; r < 16; ++r) ps += p1[r];
  ps = swap_sum(ps);
  l_reg = l_reg * alpha + ps;
  PK4(p0, 0, pa0); PK4(p0, 8, pa1); PK4(p1, 0, pa2); PK4(p1, 8, pa3);
}
template <int DQK> DEVI void qkt_acc(f32x16& p0, f32x16& p1, const char* Ks, const bf16x8* qr, int r32, int hi) {
#pragma unroll
  for (int d0 = 0; d0 < DQK / 16; ++d0) { const int cb = (d0 * 16 + hi * 8) * 2;
    const bf16x8 b0 = *reinterpret_cast<const bf16x8*>(Ks + kswz<DQK>(r32, cb));
    const bf16x8 b1 = *reinterpret_cast<const bf16x8*>(Ks + kswz<DQK>(32 + r32, cb));
    p0 = __builtin_amdgcn_mfma_f32_32x32x16_bf16(b0, qr[d0], p0, 0, 0, 0);
    p1 = __builtin_amdgcn_mfma_f32_32x32x16_bf16(b1, qr[d0], p1, 0, 0, 0); }
}
DEVI float silu_f(float g) { return g * __builtin_amdgcn_rcpf(1.f + __builtin_amdgcn_exp2f(-g * LOG2E)); }

template <int DQK, bool QNORM>
DEVI void attn_dense(const bf16* __restrict__ Qb, int ldq, const bf16* __restrict__ Kh, int ldk, const bf16* __restrict__ Vh, int ldv,
                     const bf16* __restrict__ Gb, int ldg, bf16* __restrict__ Ob, int ldo, int seq, const float* __restrict__ qgain, float negM) {
  constexpr int ND0 = DQK / 16, NCH = DQK / 8, KPT = NCH / 8;
  constexpr int SHM_V = 16384, SHM_K = 64 * DQK * 2;
  char* lds = g_smem;
  LAUNDER_TID(tid); const int wid = tid >> 6, lane = tid & 63, r32 = lane & 31, hi = lane >> 5;
  char* V_lds = lds; char* K_lds = lds + 2 * SHM_V;
  float* wsf = (float*)(lds + 2 * SHM_V + 2 * SHM_K) + wid * 64; float* li_l = wsf; float* al_l = wsf + 32;
  float l_reg = 0; f32x16 o[4] = {}; bf16x8 qr[ND0];
  const bf16* Qw = Qb + (size_t)(wid * 32 + r32) * ldq + hi * 8;
#pragma unroll
  for (int d0 = 0; d0 < ND0; ++d0) qr[d0] = *reinterpret_cast<const bf16x8*>(Qw + d0 * 16);
  if constexpr (QNORM) {
    float ss = 0.f;
#pragma unroll
    for (int d0 = 0; d0 < ND0; ++d0) { const u32x4 u = __builtin_bit_cast(u32x4, qr[d0]);
#pragma unroll
      for (int j = 0; j < 4; ++j) { const float a = bflo(u[j]), b = bfhi(u[j]); ss += a * a + b * b; } }
    ss = swap_sum(ss);
    const float rq = rsqrtf(ss * (1.f / DQK) + EPS) * (0.08838834764831845f * LOG2E);
#pragma unroll
    for (int d0 = 0; d0 < ND0; ++d0) { const u32x4 u = __builtin_bit_cast(u32x4, qr[d0]); u32x4 w;
      const f32x4 g0 = *reinterpret_cast<const f32x4*>(qgain + d0 * 16 + hi * 8), g1 = *reinterpret_cast<const f32x4*>(qgain + d0 * 16 + hi * 8 + 4);
      w[0] = cvtpk(bflo(u[0]) * rq * g0[0], bfhi(u[0]) * rq * g0[1]); w[1] = cvtpk(bflo(u[1]) * rq * g0[2], bfhi(u[1]) * rq * g0[3]);
      w[2] = cvtpk(bflo(u[2]) * rq * g1[0], bfhi(u[2]) * rq * g1[1]); w[3] = cvtpk(bflo(u[3]) * rq * g1[2], bfhi(u[3]) * rq * g1[3]);
      qr[d0] = __builtin_bit_cast(bf16x8, w); }
  }
  int kgo[KPT], vgo[2];
#pragma unroll
  for (int i = 0; i < KPT; ++i) { const int q = tid + 512 * i, row = q / NCH, chp = q % NCH;
    const int ch = (DQK == 128) ? (chp ^ (row & 7)) : (chp ^ ((row >> 1) & 7)); kgo[i] = row * ldk + ch * 8; }
#pragma unroll
  for (int i = 0; i < 2; ++i) { const int q = tid + 512 * i, st = q >> 5, kk = (st >> 2) * 8 + ((q >> 2) & 7), cc = q & 3;
    const int k = (kk & ~0xC) | ((kk & 4) << 1) | ((kk & 8) >> 1); vgo[i] = k * ldv + (st & 3) * 32 + cc * 8; }
  const int vb0 = (int)(uintptr_t)V_lds + v_rd_base(lane);
#define GLOAD(b, k0) do { const bf16* kg_ = Kh + (size_t)(k0) * ldk; const bf16* vg_ = Vh + (size_t)(k0) * ldv;               \
    _Pragma("unroll") for (int q_ = 0; q_ < KPT; ++q_) __builtin_amdgcn_global_load_lds((const unsigned*)(kg_ + kgo[q_]), (unsigned*)(K_lds + (b) * SHM_K + q_ * 8192 + tid * 16), 16, 0, 0); \
    _Pragma("unroll") for (int q_ = 0; q_ < 2; ++q_) __builtin_amdgcn_global_load_lds((const unsigned*)(vg_ + vgo[q_]), (unsigned*)(V_lds + (b) * SHM_V + q_ * 8192 + tid * 16), 16, 0, 0); } while (0)
  const int NT = seq / KVBLK;
  __syncthreads();
  GLOAD(0, 0);
  asm volatile("s_waitcnt vmcnt(0)" ::: "memory"); __syncthreads();
  for (int j = 0; j < NT; ++j) {
    const int b = j & 1;
    if (j + 1 < NT) GLOAD(b ^ 1, (j + 1) * KVBLK);
    f32x16 p0, p1; bf16x8 pa0, pa1, pa2, pa3;
#pragma unroll
    for (int r = 0; r < 16; ++r) { p0[r] = negM; p1[r] = negM; }
    qkt_acc<DQK>(p0, p1, K_lds + b * SHM_K, qr, r32, hi);
#pragma unroll
    for (int r = 0; r < 16; ++r) { p0[r] = __builtin_amdgcn_exp2f(p0[r]); p1[r] = __builtin_amdgcn_exp2f(p1[r]); }
    float ps = 0.f;
#pragma unroll
    for (int r = 0; r < 16; ++r) ps += p0[r] + p1[r];
    l_reg += ps;
    PK4(p0, 0, pa0); PK4(p0, 8, pa1); PK4(p1, 0, pa2); PK4(p1, 8, pa3);
    pv_d0(o, vb0 + b * SHM_V, pa0, pa1, pa2, pa3);
    asm volatile("s_waitcnt vmcnt(0)" ::: "memory"); __syncthreads();
  }
  l_reg = swap_sum(l_reg);
  if (hi == 0) li_l[r32] = l_reg; asm volatile("s_waitcnt lgkmcnt(0)" ::: "memory");
  const bf16* Gw = Gb + (size_t)(wid * 32) * ldg; bf16* Ow = Ob + (size_t)(wid * 32) * ldo;
#pragma unroll
  for (int r = 0; r < 16; ++r) { const int orow = crow(r, hi); const float rl = __builtin_amdgcn_rcpf(li_l[orow]);
#pragma unroll
    for (int d0 = 0; d0 < 4; ++d0) {
      const float g = __bfloat162float(Gw[(size_t)orow * ldg + d0 * 32 + r32]);
      Ow[(size_t)orow * ldo + d0 * 32 + r32] = __float2bfloat16(o[d0][r] * rl * silu_f(g));
    } }
#undef GLOAD
}

DEVI void mla_item(const Params& p, int t, float negM) {
  char* ws = p.ws; const int qb = t & 15, h = (t >> 4) & 7, b = t >> 7;
  const size_t tok0 = (size_t)b * SEQ + qb * 256, tokb = (size_t)b * SEQ;
  bf16* Q = (bf16*)(ws + OFF_Q0) + tok0 * 1536 + h * 192;
  attn_dense<192, false>(Q, 1536, (const bf16*)(ws + OFF_K0) + tokb * 1536 + h * 192, 1536, (const bf16*)(ws + OFF_V0) + tokb * 1024 + h * 128, 1024,
                         (const bf16*)p.out + tok0 * 2048 + 512 + h * 128, 2048, Q, 1536, SEQ, nullptr, negM);
}
template <int L> DEVI void mem_item(const Params& p, int t, float negM) {
  char* ws = p.ws; const int qb = t & 15, hm = (t >> 4) & 3, b = t >> 6;
  const size_t tok0 = (size_t)b * SEQ + qb * 256;
  const bf16* zb = (L == 0 ? (const bf16*)p.out : (const bf16*)(ws + OFF_Z1B)) + tok0 * 2048;
  const bf16* kv = (const bf16*)(ws + OFF_MEMKV + (size_t)L * MEMKV_BYTES) + (size_t)b * 256 * 1024 + hm * 128;
  bf16* mo = (bf16*)(ws + (L == 0 ? OFF_MEMO0 : OFF_MEMO1)) + tok0 * 512 + hm * 128;
  attn_dense<128, true>(zb + hm * 128, 2048, kv, 1024, kv + 512, 1024, zb + 512 + 1024 + hm * 128, 2048, mo, 512, 256, p.mem_q_norm + L * 128, negM);
}
DEVI float softmax_shift(const float* __restrict__ gq, const float* __restrict__ gk, int n) {
  float mq = 0.f, mk = 0.f;
  cfloat_p cq = (cfloat_p)(uintptr_t)gq, ck = (cfloat_p)(uintptr_t)gk;
  for (int i = 0; i < n; ++i) { mq = fmaxf(mq, fabsf(cq[i])); mk = fmaxf(mk, fabsf(ck[i])); }
  return -LOG2E * sqrtf((float)n) * mq * mk;
}
DEVI void phase_attn0(const Params& p) {
  const float negM_mla = softmax_shift(p.a_q_norm, p.a_k_norm, 192), negM_mem = softmax_shift(p.mem_q_norm, p.mem_k_norm, 128);
  constexpr int NJ = 1536 + 768;
  for (int it = 0;; ++it) {
    const int t = remap_tile(it); if (it * (int)gridDim.x >= NJ) break; if (t >= NJ) continue;
    if (t < 1536) mla_item(p, t, negM_mla); else mem_item<0>(p, t - 1536, negM_mem);
  }
}

DEVI void phase_knorm(const Params& p) {
  char* ws = p.ws; const bf16* z = (const bf16*)(ws + OFF_Z1A); bf16* kn = (bf16*)(ws + OFF_KN);
  LAUNDER_TID(tid);
  const long gt = (long)blockIdx.x * 512 + tid, gsz = (long)gridDim.x * 512;
  for (long i = gt; i < (long)NTOK * 16; i += gsz) {
    const long tok = i >> 4; const int c = (int)(i & 15) * 8;
    const u32x4 w = *reinterpret_cast<const u32x4*>(z + tok * 1280 + 1024 + c);
    float v[8]; float ss = 0.f;
#pragma unroll
    for (int j = 0; j < 4; ++j) { v[2 * j] = bflo(w[j]); v[2 * j + 1] = bfhi(w[j]); ss += v[2 * j] * v[2 * j] + v[2 * j + 1] * v[2 * j + 1]; }
    ss += __shfl_xor(ss, 1, 64); ss += __shfl_xor(ss, 2, 64); ss += __shfl_xor(ss, 4, 64);
    const float rr = rsqrtf(ss * (1.f / 64.f) + EPS);
    const int d = c & 63;
#pragma unroll
    for (int j = 0; j < 8; ++j) v[j] *= rr * p.b_k_norm[d + j];
    *reinterpret_cast<u32x4*>(kn + tok * 128 + c) = u32x4{cvtpk(v[0], v[1]), cvtpk(v[2], v[3]), cvtpk(v[4], v[5]), cvtpk(v[6], v[7])};
  }
}

constexpr int v_rd_off64(int d0, int ks, int half) { return ((2 * ks + half) * 2 + d0) * 512; }
template <int KS> DEVI void pv_ks64(f32x16* o, int vb, bf16x8 pa) {
  const s16x4 l0 = tr_read<v_rd_off64(0, KS, 0)>(vb), h0 = tr_read<v_rd_off64(0, KS, 1)>(vb), l1 = tr_read<v_rd_off64(1, KS, 0)>(vb), h1 = tr_read<v_rd_off64(1, KS, 1)>(vb);
  asm volatile("s_waitcnt lgkmcnt(0)" ::: "memory"); SBAR();
#define PKV(L, H) (bf16x8){L[0], L[1], L[2], L[3], H[0], H[1], H[2], H[3]}
  o[0] = __builtin_amdgcn_mfma_f32_32x32x16_bf16(pa, PKV(l0, h0), o[0], 0, 0, 0);
  o[1] = __builtin_amdgcn_mfma_f32_32x32x16_bf16(pa, PKV(l1, h1), o[1], 0, 0, 0);
#undef PKV
}
DEVI void swa_item(const Params& p, int t, float bound2) {
  char* ws = p.ws; LAUNDER_PTR(ws); char* lds = g_smem;
  const int qc = t & 127, kvh = (t >> 7) & 1, b = t >> 8;
  LAUNDER_TID(tid); const int wid = tid >> 6, lane = tid & 63, r32 = lane & 31, hi = lane >> 5;
  const int hq = kvh * 8 + wid, i0 = qc * 32; const size_t tokb = (size_t)b * SEQ;
  bf16* z1a = (bf16*)(ws + OFF_Z1A); const bf16* kn = (const bf16*)(ws + OFF_KN); const bf16* z1b = (const bf16*)(ws + OFF_Z1B);
  char* K_lds = lds; char* V_lds = lds + 5 * 8192; float* li_l = (float*)(lds + 10 * 8192) + wid * 64;
  const int ts0 = (i0 - 128) & ~63;
  const int jlo = ts0 < 0 ? (-ts0) >> 6 : 0, jhi = min(5, (SEQ - ts0) >> 6);
  __syncthreads();
  {
    const int krow = tid >> 3, kch = (tid & 7) ^ ((krow >> 1) & 7);
    const int st = tid >> 5, kk = (st >> 1) * 8 + ((tid >> 2) & 7), vk = (kk & ~0xC) | ((kk & 4) << 1) | ((kk & 8) >> 1), vcol = (st & 1) * 32 + (tid & 3) * 8;
    const bf16* kg = kn + (tokb + ts0 + krow) * 128 + kvh * 64 + kch * 8;
    const bf16* vg = z1a + (tokb + ts0 + vk) * 1280 + 1152 + kvh * 64 + vcol;
    for (int j = jlo; j < jhi; ++j) {
      __builtin_amdgcn_global_load_lds((const unsigned*)(kg + (size_t)j * 64 * 128), (unsigned*)(K_lds + j * 8192 + tid * 16), 16, 0, 0);
      __builtin_amdgcn_global_load_lds((const unsigned*)(vg + (size_t)j * 64 * 1280), (unsigned*)(V_lds + j * 8192 + tid * 16), 16, 0, 0);
    }
  }
  const bf16* Gw = z1b + (tokb + i0) * 2048 + 512 + hq * 64 + r32;
  unsigned gpk[16];
#pragma unroll
  for (int r = 0; r < 16; ++r) { const int orow = crow(r, hi);
    const unsigned g0 = *reinterpret_cast<const unsigned short*>(Gw + (size_t)orow * 2048), g1 = *reinterpret_cast<const unsigned short*>(Gw + (size_t)orow * 2048 + 32);
    gpk[r] = g0 | (g1 << 16); }
  bf16* Qw = z1a + (tokb + i0 + r32) * 1280 + hq * 64;
  bf16x8 qr[4];
  { float ss = 0.f; u32x4 u[4];
#pragma unroll
    for (int d0 = 0; d0 < 4; ++d0) { u[d0] = *reinterpret_cast<const u32x4*>(Qw + d0 * 16 + hi * 8);
#pragma unroll
      for (int j = 0; j < 4; ++j) { const float a = bflo(u[d0][j]), c = bfhi(u[d0][j]); ss += a * a + c * c; } }
    ss = swap_sum(ss);
    const float rq = rsqrtf(ss * (1.f / 64.f) + EPS) * (0.125f * LOG2E);
#pragma unroll
    for (int d0 = 0; d0 < 4; ++d0) { u32x4 w;
      const f32x4 g0 = *reinterpret_cast<const f32x4*>(p.b_q_norm + d0 * 16 + hi * 8), g1 = *reinterpret_cast<const f32x4*>(p.b_q_norm + d0 * 16 + hi * 8 + 4);
      w[0] = cvtpk(bflo(u[d0][0]) * rq * g0[0], bfhi(u[d0][0]) * rq * g0[1]); w[1] = cvtpk(bflo(u[d0][1]) * rq * g0[2], bfhi(u[d0][1]) * rq * g0[3]);
      w[2] = cvtpk(bflo(u[d0][2]) * rq * g1[0], bfhi(u[d0][2]) * rq * g1[1]); w[3] = cvtpk(bflo(u[d0][3]) * rq * g1[2], bfhi(u[d0][3]) * rq * g1[3]);
      qr[d0] = __builtin_bit_cast(bf16x8, w); }
  }
  const float slope2 = exp2f(-0.5f * (float)(hq + 1)) * LOG2E, sink2 = p.b_sink[hq] * LOG2E;
  const float negM = -fmaxf(bound2, sink2);
  float l_reg = 0.f;
  f32x16 o[2] = {};
  const int vb0 = (int)(uintptr_t)V_lds + v_rd_base(lane);
  const int query = i0 + r32;
  asm volatile("s_waitcnt vmcnt(0)" ::: "memory"); __syncthreads();
  for (int j = jlo; j < jhi; ++j) {
    const int ts = ts0 + 64 * j; const char* Kt = K_lds + j * 8192;
    f32x16 p0, p1;
#pragma unroll
    for (int r = 0; r < 16; ++r) { p0[r] = negM; p1[r] = negM; }
#pragma unroll
    for (int d0 = 0; d0 < 4; ++d0) { const int ch = d0 * 2 + hi;
      const bf16x8 b0 = *reinterpret_cast<const bf16x8*>(Kt + swz128(r32, ch));
      const bf16x8 b1 = *reinterpret_cast<const bf16x8*>(Kt + swz128(32 + r32, ch));
      p0 = __builtin_amdgcn_mfma_f32_32x32x16_bf16(b0, qr[d0], p0, 0, 0, 0);
      p1 = __builtin_amdgcn_mfma_f32_32x32x16_bf16(b1, qr[d0], p1, 0, 0, 0); }
    const float fb0 = (float)(ts - query + 4 * hi), fb1 = fb0 + 32.f;
    const bool full = (ts - (i0 + 31) >= -128) && (ts + 63 - i0 <= 128);
    float ps = 0.f;
    if (full) {
#pragma unroll
      for (int r = 0; r < 16; ++r) { const float off = (float)((r & 3) + 8 * (r >> 2));
        p0[r] = __builtin_amdgcn_exp2f(fmaf(-slope2, fabsf(fb0 + off), p0[r]));
        p1[r] = __builtin_amdgcn_exp2f(fmaf(-slope2, fabsf(fb1 + off), p1[r]));
        ps += p0[r] + p1[r]; }
    } else {
#pragma unroll
      for (int r = 0; r < 16; ++r) { const float off = (float)((r & 3) + 8 * (r >> 2));
        const float e0 = fabsf(fb0 + off), e1 = fabsf(fb1 + off);
        p0[r] = e0 <= 128.f ? __builtin_amdgcn_exp2f(fmaf(-slope2, e0, p0[r])) : 0.f;
        p1[r] = e1 <= 128.f ? __builtin_amdgcn_exp2f(fmaf(-slope2, e1, p1[r])) : 0.f;
        ps += p0[r] + p1[r]; }
    }
    l_reg += ps;
    const int vb = vb0 + j * 8192; bf16x8 pa;
    PK4(p0, 0, pa); pv_ks64<0>(o, vb, pa); PK4(p0, 8, pa); pv_ks64<1>(o, vb, pa);
    PK4(p1, 0, pa); pv_ks64<2>(o, vb, pa); PK4(p1, 8, pa); pv_ks64<3>(o, vb, pa);
  }
  l_reg = swap_sum(l_reg) + __builtin_amdgcn_exp2f(sink2 + negM);
  if (hi == 0) li_l[r32] = l_reg; asm volatile("s_waitcnt lgkmcnt(0)" ::: "memory");
  bf16* Ow = z1a + (tokb + i0) * 1280 + hq * 64 + r32;
#pragma unroll
  for (int r = 0; r < 16; ++r) { const int orow = crow(r, hi); const float rl = __builtin_amdgcn_rcpf(li_l[orow]);
    Ow[(size_t)orow * 1280] = __float2bfloat16(o[0][r] * rl * silu_f(bflo(gpk[r])));
    Ow[(size_t)orow * 1280 + 32] = __float2bfloat16(o[1][r] * rl * silu_f(bfhi(gpk[r])));
  }
}
DEVI void phase_attn1(const Params& p) {
  const float negM_mem = softmax_shift(p.mem_q_norm + 128, p.mem_k_norm + 128, 128), bound2_swa = -softmax_shift(p.b_q_norm, p.b_k_norm, 64);
  constexpr int NJ = 3072 + 768;
  for (int it = 0;; ++it) {
    const int t = remap_tile(it); if (it * (int)gridDim.x >= NJ) break; if (t >= NJ) continue;
    if (t < 768) mem_item<1>(p, t, negM_mem); else swa_item(p, t - 768, bound2_swa);
  }
}

template <int PH> DEVI void run_phase(const Params& p) {
  if constexpr (PH == 0) phase_prep(p);
  else if constexpr (PH == 1) phase_gemm1(p);
  else if constexpr (PH == 2) phase_p2(p);
  else if constexpr (PH == 3) phase_attn0(p);
  else if constexpr (PH == 4) phase_gemm_simple<G_OUT0>(p, 4);
  else if constexpr (PH == 5) phase_gemm_simple<G_Z1>(p, 13);
  else if constexpr (PH == 6) phase_knorm(p);
  else if constexpr (PH == 7) phase_attn1(p);
  else phase_gemm_simple<G_OUT1>(p, 4);
}
#if MK_COOP
__global__ __launch_bounds__(512) void mega_coop(Params p) {
  cg::grid_group grid = cg::this_grid();
  phase_prep(p); grid.sync();
  phase_gemm1(p); grid.sync();
  phase_p2(p); grid.sync();
  phase_attn0(p); grid.sync();
  phase_gemm_simple<G_OUT0>(p, 4); grid.sync();
  phase_gemm_simple<G_Z1>(p, 13); grid.sync();
  phase_knorm(p); grid.sync();
  phase_attn1(p); grid.sync();
  phase_gemm_simple<G_OUT1>(p, 4);
}
#endif
template <int PH> __global__ __launch_bounds__(512) void mega_phase(Params p) { run_phase<PH>(p); }

extern "C" void kernel_launch(void* const* d_in, const int* in_sizes, int n_in, void* d_out, int out_size, void* d_ws, size_t ws_size, hipStream_t stream) {
  static int grid = 0;
  if (grid == 0) {
    if (n_in != 21 || out_size != NTOK * 1024 || ws_size < WS_NEED) { fprintf(stderr, "kernel_launch: unexpected shapes n_in %d out %d ws %zu\n", n_in, out_size, ws_size); grid = -1; return; }
    int dev = 0, cus = 0, per_cu = 0;
    (void)hipGetDevice(&dev); (void)hipDeviceGetAttribute(&cus, hipDeviceAttributeMultiprocessorCount, dev);
#if MK_COOP
    (void)hipFuncSetAttribute((const void*)mega_coop, hipFuncAttributeMaxDynamicSharedMemorySize, LDS_BYTES);
    (void)hipOccupancyMaxActiveBlocksPerMultiprocessor(&per_cu, (const void*)mega_coop, 512, LDS_BYTES);
#else
#define SETATTR(PH) (void)hipFuncSetAttribute((const void*)mega_phase<PH>, hipFuncAttributeMaxDynamicSharedMemorySize, LDS_BYTES)
    SETATTR(0); SETATTR(1); SETATTR(2); SETATTR(3); SETATTR(4); SETATTR(5); SETATTR(6); SETATTR(7); SETATTR(8);
    per_cu = 1;
#endif
    if (per_cu < 1) { fprintf(stderr, "kernel_launch: occupancy query says %d blocks/CU\n", per_cu); per_cu = 1; }
    grid = cus * 1;
  }
  if (grid < 0) return;
  { static const int exp_sz[21] = {8*4096*1024, 4*4096*1024, 8*256*1024, 4*256*1024, 2*1024, 2*1536*1024, 2*1024, 2*1024*1024, 2*128, 2*128,
      1024*2752, 384, 384*1536, 256, 256*2048, 192, 192, 1024*3328, 64, 64, 16};
    for (int i = 0; i < 21; ++i) if (in_sizes[i] != exp_sz[i]) { fprintf(stderr, "in_sizes[%d] = %d != %d\n", i, in_sizes[i], exp_sz[i]);
      return; } }
  Params p{};
  const float** pp = (const float**)&p;
  for (int i = 0; i < 21; ++i) pp[i] = (const float*)d_in[i];
  p.out = (float*)d_out; p.ws = (char*)d_ws;
#if MK_COOP
  void* args[] = {&p};
  hipError_t e = hipLaunchCooperativeKernel((const void*)mega_coop, dim3(grid), dim3(512), args, LDS_BYTES, stream);
  if (e != hipSuccess) fprintf(stderr, "cooperative launch failed: %s (grid %d)\n", hipGetErrorString(e), grid);
#else
#define LAUNCH(PH) hipLaunchKernelGGL(mega_phase<PH>, dim3(grid), dim3(512), LDS_BYTES, stream, p)
  LAUNCH(0); LAUNCH(1); LAUNCH(2); LAUNCH(3); LAUNCH(4); LAUNCH(5); LAUNCH(6); LAUNCH(7); LAUNCH(8);
#endif
}
```

```cpp
#include <hip/hip_runtime.h>
#include <hip/hip_bf16.h>
#include <hip/hip_cooperative_groups.h>
#include <cstdio>
#include <cstdint>
namespace cg = cooperative_groups;

#ifndef MK_COOP
#define MK_COOP 1
#endif

using bf16   = __hip_bfloat16;
using bf16x8 = __attribute__((ext_vector_type(8))) short;
using s16x4  = __attribute__((ext_vector_type(4))) short;
using f32x16 = __attribute__((ext_vector_type(16))) float;
using f32x4  = __attribute__((ext_vector_type(4))) float;
using u32x4  = __attribute__((ext_vector_type(4))) unsigned;
using u32x2  = __attribute__((ext_vector_type(2))) unsigned;
using bf2_t  = __attribute__((ext_vector_type(2))) __bf16;
#define DEVI __device__ __forceinline__
typedef const __attribute__((address_space(4))) float* cfloat_p;
#define SBAR() __builtin_amdgcn_sched_barrier(0)
#define LAUNDER_TID(tid) int tid = threadIdx.x; asm volatile("" : "+v"(tid))
#define LAUNDER_PTR(ptr) asm volatile("" : "+s"(ptr))

constexpr int NTOK = 49152, SEQ = 4096, NPROMPT_TOK = 32768;
constexpr int NMEMROW = 3072, NPROMPT_MEM = 2048;
constexpr float EPS = 1e-6f;
constexpr float LOG2E = 1.4426950408889634f;

constexpr size_t MiB = 1ull << 20;
constexpr size_t WA_BYTES = 2816ull * 1024 * 2, WB_BYTES = 3328ull * 1024 * 2, WO_BYTES = 1024ull * 1536 * 2, WM_BYTES = 1024ull * 1024 * 2;
constexpr size_t WQ_BYTES = 1536ull * 384 * 2, WKV_BYTES = 2048ull * 256 * 2, MEMKV_BYTES = 3072ull * 1024 * 2;
constexpr size_t OFF_WA = 0;
constexpr size_t OFF_WB = OFF_WA + WA_BYTES;
constexpr size_t OFF_WO = OFF_WB + WB_BYTES;
constexpr size_t OFF_WM = OFF_WO + 2 * WO_BYTES;
constexpr size_t OFF_WQ = OFF_WM + 2 * WM_BYTES;
constexpr size_t OFF_WKV = OFF_WQ + WQ_BYTES;
constexpr size_t OFF_MEMKV = OFF_WKV + WKV_BYTES;
constexpr size_t OFF_MEMB = OFF_MEMKV + 2 * MEMKV_BYTES;
constexpr size_t OFF_SS0 = OFF_MEMB + 3072ull * 1024 * 2;
constexpr size_t OFF_SS1 = OFF_SS0 + NTOK * 4ull;
constexpr size_t OFF_SSM = OFF_SS1 + NTOK * 4ull;
constexpr size_t OFF_ROPE = OFF_SSM + NMEMROW * 4ull;
constexpr size_t OFF_W_END = OFF_ROPE + 2ull * 4096 * 32 * 4;
static_assert(OFF_W_END <= 60 * MiB, "weight region overflow");
constexpr size_t OFF_XB = 60 * MiB, OFF_Q0 = 60 * MiB, OFF_K0 = 204 * MiB, OFF_V0 = 348 * MiB, OFF_ZA = 446 * MiB, OFF_MEMO0 = 446 * MiB;
constexpr size_t OFF_X1B = 204 * MiB, OFF_Z1A = 60 * MiB, OFF_KN = 180 * MiB, OFF_MEMO1 = 204 * MiB, OFF_Z1B = 300 * MiB;
constexpr size_t WS_NEED = 512 * MiB;

struct Params {
  const float *x_prompt, *x_sample, *mem_prompt, *mem_sample, *norm_in, *w_out, *mem_norm, *w_mem_kv, *mem_q_norm, *mem_k_norm;
  const float *a_w_in, *a_q_a_norm, *a_w_q_b, *a_kv_a_norm, *a_w_kv_b, *a_q_norm, *a_k_norm, *b_w_in, *b_q_norm, *b_k_norm, *b_sink;
  float* out; char* ws;
};

extern __shared__ __attribute__((aligned(16))) char g_smem[];
constexpr int LDS_BYTES = 131072;

DEVI int crow(int r, int hi) { return (r & 3) + 8 * (r >> 2) + 4 * hi; }
DEVI unsigned cvtpk(float lo, float hi) { unsigned r; asm volatile("v_cvt_pk_bf16_f32 %0, %1, %2" : "=v"(r) : "v"(lo), "v"(hi)); return r; }
DEVI float bflo(unsigned w) { return __uint_as_float(w << 16); }
DEVI float bfhi(unsigned w) { return __uint_as_float(w & 0xffff0000u); }
DEVI float swap_sum(float v) { auto rr = __builtin_amdgcn_permlane32_swap(__float_as_uint(v), __float_as_uint(v), false, false); return __uint_as_float(rr[0]) + __uint_as_float(rr[1]); }
DEVI float swap_max(float v) { auto rr = __builtin_amdgcn_permlane32_swap(__float_as_uint(v), __float_as_uint(v), false, false); return fmaxf(__uint_as_float(rr[0]), __uint_as_float(rr[1])); }
#define PK4(P, BASE, OUT) do { unsigned a0_ = cvtpk(P[BASE + 0], P[BASE + 1]), a1_ = cvtpk(P[BASE + 2], P[BASE + 3]);   \
    unsigned b0_ = cvtpk(P[BASE + 4], P[BASE + 5]), b1_ = cvtpk(P[BASE + 6], P[BASE + 7]);                              \
    auto r0_ = __builtin_amdgcn_permlane32_swap(a0_, b0_, false, false); auto r1_ = __builtin_amdgcn_permlane32_swap(a1_, b1_, false, false); \
    u32x4 w_ = {r0_[0], r1_[0], r0_[1], r1_[1]}; OUT = __builtin_bit_cast(bf16x8, w_); } while (0)
DEVI const float* x_row(const Params& p, int tok) { return tok < NPROMPT_TOK ? p.x_prompt + (size_t)tok * 1024 : p.x_sample + (size_t)(tok - NPROMPT_TOK) * 1024; }
DEVI const float* mem_row(const Params& p, int r) { return r < NPROMPT_MEM ? p.mem_prompt + (size_t)r * 1024 : p.mem_sample + (size_t)(r - NPROMPT_MEM) * 1024; }
DEVI int remap_tile(int it) {
  const int G = gridDim.x, b = blockIdx.x;
  return (G & 7) ? it * G + b : it * G + (b & 7) * (G >> 3) + (b >> 3);
}

DEVI void wt_job(const float* __restrict__ W, const float* __restrict__ g, bf16* __restrict__ out, int K, int N, int Npad, long gt, long gsz) {
  const int nq = Npad >> 2; const long total = (long)nq * (K >> 3);
  for (long i = gt; i < total; i += gsz) {
    const int n4 = (int)(i % nq) << 2; const int k0 = (int)(i / nq) << 3;
    f32x4 v[8];
    if (n4 < N) {
#pragma unroll
      for (int j = 0; j < 8; ++j) { v[j] = *reinterpret_cast<const f32x4*>(W + (size_t)(k0 + j) * N + n4); const float gj = g ? g[k0 + j] : 1.f; v[j][0] *= gj; v[j][1] *= gj; v[j][2] *= gj; v[j][3] *= gj; }
    } else {
#pragma unroll
      for (int j = 0; j < 8; ++j) v[j] = f32x4{0.f, 0.f, 0.f, 0.f};
    }
#pragma unroll
    for (int c = 0; c < 4; ++c)
      *reinterpret_cast<u32x4*>(out + (size_t)(n4 + c) * K + k0) = u32x4{cvtpk(v[0][c], v[1][c]), cvtpk(v[2][c], v[3][c]), cvtpk(v[4][c], v[5][c]), cvtpk(v[6][c], v[7][c])};
  }
}
DEVI void row_job4(const Params& p, int r0, int lane) {
  char* ws = p.ws;
  f32x4 v[4][4];
#pragma unroll
  for (int k = 0; k < 4; ++k) { const int r = r0 + k;
    const float* src = r < NTOK ? x_row(p, r) : mem_row(p, r - NTOK);
#pragma unroll
    for (int i = 0; i < 2; ++i) { v[k][2 * i] = *reinterpret_cast<const f32x4*>(src + lane * 8 + 512 * i); v[k][2 * i + 1] = *reinterpret_cast<const f32x4*>(src + lane * 8 + 512 * i + 4); } }
#pragma unroll
  for (int k = 0; k < 4; ++k) { const int r = r0 + k;
    bf16* dst = r < NTOK ? (bf16*)(ws + OFF_XB) + (size_t)r * 1024 : (bf16*)(ws + OFF_MEMB) + (size_t)(r - NTOK) * 1024;
    float ss = 0.f;
#pragma unroll
    for (int i = 0; i < 2; ++i) { const f32x4 a = v[k][2 * i], c = v[k][2 * i + 1];
      ss += a[0] * a[0] + a[1] * a[1] + a[2] * a[2] + a[3] * a[3] + c[0] * c[0] + c[1] * c[1] + c[2] * c[2] + c[3] * c[3];
      *reinterpret_cast<u32x4*>(dst + lane * 8 + 512 * i) = u32x4{cvtpk(a[0], a[1]), cvtpk(a[2], a[3]), cvtpk(c[0], c[1]), cvtpk(c[2], c[3])}; }
#pragma unroll
    for (int o = 32; o > 0; o >>= 1) ss += __shfl_xor(ss, o, 64);
    if (lane == 0) { if (r < NTOK) ((float*)(ws + OFF_SS0))[r] = ss; else ((float*)(ws + OFF_SSM))[r - NTOK] = ss; }
  }
}
DEVI void phase_prep(const Params& p) {
  char* ws = p.ws; LAUNDER_TID(tid);
  const long gt = (long)blockIdx.x * 512 + tid, gsz = (long)gridDim.x * 512;
  wt_job(p.a_w_in, p.norm_in, (bf16*)(ws + OFF_WA), 1024, 2752, 2816, gt, gsz);
  wt_job(p.b_w_in, p.norm_in + 1024, (bf16*)(ws + OFF_WB), 1024, 3328, 3328, gt, gsz);
  wt_job(p.w_out, nullptr, (bf16*)(ws + OFF_WO), 1536, 1024, 1024, gt, gsz);
  wt_job(p.w_out + 1536 * 1024, nullptr, (bf16*)(ws + OFF_WO + WO_BYTES), 1536, 1024, 1024, gt, gsz);
  wt_job(p.w_mem_kv, p.mem_norm, (bf16*)(ws + OFF_WM), 1024, 1024, 1024, gt, gsz);
  wt_job(p.w_mem_kv + 1024 * 1024, p.mem_norm + 1024, (bf16*)(ws + OFF_WM + WM_BYTES), 1024, 1024, 1024, gt, gsz);
  wt_job(p.a_w_q_b, p.a_q_a_norm, (bf16*)(ws + OFF_WQ), 384, 1536, 1536, gt, gsz);
  wt_job(p.a_w_kv_b, p.a_kv_a_norm, (bf16*)(ws + OFF_WKV), 256, 2048, 2048, gt, gsz);
  float* rc = (float*)(ws + OFF_ROPE); float* rs = rc + 4096 * 32;
  for (long i = gt; i < 4096 * 32; i += gsz) {
    const int pos = (int)(i >> 5), f = (int)(i & 31);
    const float inv = exp2f(-(float)f * (13.287712379549449f / 32.f));
    float rev = (float)pos * inv * 0.15915494309189535f; rev -= floorf(rev);
    rc[i] = __builtin_amdgcn_cosf(rev); rs[i] = __builtin_amdgcn_sinf(rev);
  }
  float* ss1 = (float*)(ws + OFF_SS1);
  for (long i = gt; i < NTOK; i += gsz) ss1[i] = 0.f;
  const int wid = tid >> 6, lane = tid & 63;
  const int nw = gridDim.x * 8;
  for (int r = (blockIdx.x * 8 + wid) * 4; r < NTOK + NMEMROW; r += nw * 4) row_job4(p, r, lane);
}

enum { G_Z0 = 0, G_MKV0 = 1, G_MKV1 = 2, G_OUT0 = 3, G_Z1 = 4, G_OUT1 = 5 };
constexpr int BK = 64, HALF = 128, HT = HALF * BK;
DEVI int lds_byte(int r, int c) { int st = (r >> 4) * 2 + (c >> 5), rr = r & 15, cc = c & 31, ob = rr * 64 + cc * 2; return st * 1024 + (ob ^ (((ob >> 9) & 1) << 5)); }
DEVI void stage_rc(int b, int& R, int& C) { int st = b / 1024, sb = b % 1024, swz = sb ^ (((sb >> 9) & 1) << 5); R = (st >> 1) * 16 + swz / 64; C = (st & 1) * 32 + (swz % 64) / 2; }

template <int MODE> DEVI const bf16* a_ptr(const Params& p, int kt, int& lda) {
  char* ws = p.ws; const int k = kt * 64;
  if constexpr (MODE == G_Z0) { lda = 1024; return (const bf16*)(ws + OFF_XB) + k; }
  else if constexpr (MODE == G_MKV0 || MODE == G_MKV1) { lda = 1024; return (const bf16*)(ws + OFF_MEMB) + k; }
  else if constexpr (MODE == G_Z1) { lda = 1024; return (const bf16*)(ws + OFF_X1B) + k; }
  else if constexpr (MODE == G_OUT0) {
    if (k < 1024) { lda = 1536; return (const bf16*)(ws + OFF_Q0) + (k >> 7) * 192 + (k & 127); }
    lda = 512; return (const bf16*)(ws + OFF_MEMO0) + (k - 1024);
  } else {
    if (k < 1024) { lda = 1280; return (const bf16*)(ws + OFF_Z1A) + k; }
    lda = 512; return (const bf16*)(ws + OFF_MEMO1) + (k - 1024);
  }
}

template <int MODE>
DEVI void gemm_tile(const Params& p, int pm, int pn) {
  constexpr int K = (MODE == G_OUT0 || MODE == G_OUT1) ? 1536 : 1024;
  constexpr int nt = K / BK;
  char* ws = p.ws; LAUNDER_TID(tid);
  const bf16* Bt = (const bf16*)(ws + (MODE == G_Z0 ? OFF_WA : MODE == G_MKV0 ? OFF_WM : MODE == G_MKV1 ? OFF_WM + WM_BYTES : MODE == G_OUT0 ? OFF_WO : MODE == G_Z1 ? OFF_WB : OFF_WO + WO_BYTES));
  bf16* shm = (bf16*)g_smem;
  const int brow = pm * 256, bcol = pn * 256;
#define SA(b, h) (shm + ((b) * 2 + (h)) * HT)
#define SB(b, h) (shm + (4 + (b) * 2 + (h)) * HT)
#define STAGE_B(P, half, kt) do { const bf16* _g = Bt + (size_t)(bcol + (half) * HALF) * K + (size_t)(kt) * BK;              \
    _Pragma("unroll") for (int _i = 0; _i < 2; ++_i)                                                                          \
      __builtin_amdgcn_global_load_lds((const unsigned*)(_g + ((st_rc[_i] & 255) * K + (st_rc[_i] >> 8))), (unsigned*)((char*)(P) + tid * 16 + _i * 8192), 16, 0, 0); } while (0)
#define STAGE_A(P, half, kt) do { int _lda; const bf16* _g = a_ptr<MODE>(p, (kt), _lda) + (size_t)(brow + (half) * HALF) * _lda; \
    _Pragma("unroll") for (int _i = 0; _i < 2; ++_i)                                                                          \
      __builtin_amdgcn_global_load_lds((const unsigned*)(_g + ((st_rc[_i] & 255) * _lda + (st_rc[_i] >> 8))), (unsigned*)((char*)(P) + tid * 16 + _i * 8192), 16, 0, 0); } while (0)
#define LDA(dst, b, h) for (int m = 0; m < 4; ++m) for (int k = 0; k < 2; ++k) \
    dst[m][k] = *reinterpret_cast<const bf16x8*>((char*)SA(b, h) + lds_byte(wr * 64 + m * 16 + fr, k * 32 + fq * 8))
#define LDB(dst, b, h) for (int n = 0; n < 2; ++n) for (int k = 0; k < 2; ++k) \
    dst[n][k] = *reinterpret_cast<const bf16x8*>((char*)SB(b, h) + lds_byte(wc * 32 + n * 16 + fr, k * 32 + fq * 8))
#define MMA(ai, bj, At_, Bt_) do { __builtin_amdgcn_s_setprio(1); \
    for (int m = 0; m < 4; ++m) for (int n = 0; n < 2; ++n) for (int k = 0; k < 2; ++k) \
      acc[ai][bj][m][n] = __builtin_amdgcn_mfma_f32_16x16x32_bf16(Bt_[n][k], At_[m][k], acc[ai][bj][m][n], 0, 0, 0); \
    __builtin_amdgcn_s_setprio(0); } while (0)
#define WAIT_V(n) asm volatile("s_waitcnt vmcnt(" #n ")" ::: "memory")
#define WAIT_L(n) asm volatile("s_waitcnt lgkmcnt(" #n ")" ::: "memory")
#define BAR __builtin_amdgcn_s_barrier()
  const int wid = tid >> 6, lane = tid & 63, wr = wid >> 2, wc = wid & 3, fr = lane & 15, fq = lane >> 4;
  f32x4 acc[2][2][4][2] = {};
  bf16x8 At[4][2], B0[2][2], B1[2][2];
  int st_rc[2];
#pragma unroll
  for (int i = 0; i < 2; ++i) { int r_, c_; stage_rc(tid * 16 + i * 8192, r_, c_); st_rc[i] = r_ | (c_ << 8); }
  __syncthreads();
  STAGE_B(SB(0, 0), 0, 0); STAGE_A(SA(0, 0), 0, 0);
  STAGE_B(SB(0, 1), 1, 0); STAGE_A(SA(0, 1), 1, 0);
  if (wr == 1) BAR;
  WAIT_V(4); BAR;
  STAGE_B(SB(1, 0), 0, 1); STAGE_A(SA(1, 0), 0, 1); STAGE_B(SB(1, 1), 1, 1);
  WAIT_V(6); BAR;
  for (int t = 0; t < nt - 2; t += 2) {
    LDB(B0, 0, 0); SBAR(); LDA(At, 0, 0); STAGE_A(SA(1, 1), 1, t + 1);
    WAIT_L(8); BAR; WAIT_L(0); MMA(0, 0, At, B0); BAR; SBAR();
    LDB(B1, 0, 1); STAGE_B(SB(0, 0), 0, t + 2);
    BAR; WAIT_L(0); MMA(0, 1, At, B1); BAR;
    LDA(At, 0, 1); STAGE_A(SA(0, 0), 0, t + 2);
    BAR; WAIT_L(0); MMA(1, 0, At, B0); BAR; SBAR();
    STAGE_B(SB(0, 1), 1, t + 2);
    WAIT_V(6); BAR; MMA(1, 1, At, B1); BAR;
    LDB(B0, 1, 0); SBAR(); LDA(At, 1, 0); STAGE_A(SA(0, 1), 1, t + 2);
    WAIT_L(8); BAR; WAIT_L(0); MMA(0, 0, At, B0); BAR; SBAR();
    LDB(B1, 1, 1); STAGE_B(SB(1, 0), 0, t + 3);
    BAR; WAIT_L(0); MMA(0, 1, At, B1); BAR;
    LDA(At, 1, 1); STAGE_A(SA(1, 0), 0, t + 3);
    BAR; WAIT_L(0); MMA(1, 0, At, B0); BAR; SBAR();
    STAGE_B(SB(1, 1), 1, t + 3);
    WAIT_V(6); BAR; MMA(1, 1, At, B1); BAR;
  }
  { LDB(B0, 0, 0); LDA(At, 0, 0); STAGE_A(SA(1, 1), 1, nt - 1);
    BAR; WAIT_L(0); MMA(0, 0, At, B0); BAR;
    LDB(B1, 0, 1); BAR; WAIT_L(0); MMA(0, 1, At, B1); BAR;
    LDA(At, 0, 1); WAIT_V(4); BAR; WAIT_L(0); MMA(1, 0, At, B0); MMA(1, 1, At, B1); BAR; }
  { LDB(B0, 1, 0); LDA(At, 1, 0); WAIT_V(2); BAR; WAIT_L(0); MMA(0, 0, At, B0); BAR;
    LDB(B1, 1, 1); WAIT_V(0); BAR; WAIT_L(0); MMA(0, 1, At, B1); BAR;
    LDA(At, 1, 1); BAR; WAIT_L(0); MMA(1, 0, At, B0); MMA(1, 1, At, B1); BAR; }
  if (wr == 0) BAR;
#undef SA
#undef SB
#undef STAGE_A
#undef STAGE_B
#undef LDA
#undef LDB
#undef MMA
  float rs8[2][4];
  if constexpr (MODE == G_Z0 || MODE == G_Z1 || MODE == G_MKV0 || MODE == G_MKV1) {
    const float* ssp = (const float*)(ws + (MODE == G_Z0 ? OFF_SS0 : MODE == G_Z1 ? OFF_SS1 : OFF_SSM));
#pragma unroll
    for (int ai = 0; ai < 2; ++ai)
#pragma unroll
      for (int m = 0; m < 4; ++m) rs8[ai][m] = ssp[brow + ai * HALF + wr * 64 + m * 16 + fr];
#pragma unroll
    for (int ai = 0; ai < 2; ++ai)
#pragma unroll
      for (int m = 0; m < 4; ++m) rs8[ai][m] = rsqrtf(rs8[ai][m] * (1.f / 1024.f) + EPS);
  }
#pragma unroll
  for (int ai = 0; ai < 2; ++ai) {
    f32x4 resv[4][4];
    if constexpr (MODE == G_OUT0 || MODE == G_OUT1) {
#pragma unroll
      for (int m = 0; m < 4; ++m) { const int row = brow + ai * HALF + wr * 64 + m * 16 + fr;
        const float* res = (MODE == G_OUT0) ? x_row(p, row) : p.out + (size_t)row * 1024;
#pragma unroll
        for (int bj = 0; bj < 2; ++bj)
#pragma unroll
          for (int n = 0; n < 2; ++n) resv[m][bj * 2 + n] = *reinterpret_cast<const f32x4*>(res + bcol + bj * HALF + wc * 32 + n * 16 + fq * 4); }
    }
#pragma unroll
    for (int m = 0; m < 4; ++m) {
      const int row = brow + ai * HALF + wr * 64 + m * 16 + fr;
      if constexpr (MODE == G_Z0 || MODE == G_Z1 || MODE == G_MKV0 || MODE == G_MKV1) {
        const float rs = rs8[ai][m];
#pragma unroll
        for (int bj = 0; bj < 2; ++bj) {
          const f32x4 a0 = acc[ai][bj][m][0], a1 = acc[ai][bj][m][1];
          const unsigned x0 = cvtpk(a0[0] * rs, a0[1] * rs), x1 = cvtpk(a0[2] * rs, a0[3] * rs);
          const unsigned y0 = cvtpk(a1[0] * rs, a1[1] * rs), y1 = cvtpk(a1[2] * rs, a1[3] * rs);
          const auto s0 = __builtin_amdgcn_permlane16_swap(x0, y0, false, false), s1 = __builtin_amdgcn_permlane16_swap(x1, y1, false, false);
          const u32x4 w = {s0[0], s1[0], s0[1], s1[1]};
          const int col = bcol + bj * HALF + wc * 32 + (fq & 1) * 16 + (fq >> 1) * 8;
          if constexpr (MODE == G_Z0) {
            if (col < 704) *reinterpret_cast<u32x4*>((bf16*)(ws + OFF_ZA) + (size_t)row * 704 + col) = w;
            else if (col < 2752) *reinterpret_cast<u32x4*>((bf16*)p.out + (size_t)row * 2048 + (col - 704)) = w;
          } else if constexpr (MODE == G_Z1) {
            if (col < 1280) *reinterpret_cast<u32x4*>((bf16*)(ws + OFF_Z1A) + (size_t)row * 1280 + col) = w;
            else *reinterpret_cast<u32x4*>((bf16*)(ws + OFF_Z1B) + (size_t)row * 2048 + (col - 1280)) = w;
          } else {
            *reinterpret_cast<u32x4*>((bf16*)(ws + OFF_MEMKV + (MODE == G_MKV1 ? MEMKV_BYTES : 0)) + (size_t)row * 1024 + col) = w;
          }
        }
      } else {
        float* dst = p.out + (size_t)row * 1024;
        float ssl = 0.f;
#pragma unroll
        for (int bj = 0; bj < 2; ++bj)
#pragma unroll
          for (int n = 0; n < 2; ++n) {
            const int col = bcol + bj * HALF + wc * 32 + n * 16 + fq * 4;
            const f32x4 a = acc[ai][bj][m][n];
            f32x4 x = resv[m][bj * 2 + n];
            x[0] += a[0]; x[1] += a[1]; x[2] += a[2]; x[3] += a[3];
            *reinterpret_cast<f32x4*>(dst + col) = x;
            if constexpr (MODE == G_OUT0) {
              ssl += x[0] * x[0] + x[1] * x[1] + x[2] * x[2] + x[3] * x[3];
              *reinterpret_cast<u32x2*>((bf16*)(ws + OFF_X1B) + (size_t)row * 1024 + col) = u32x2{cvtpk(x[0], x[1]), cvtpk(x[2], x[3])};
            }
          }
        if constexpr (MODE == G_OUT0) {
          ssl += __shfl_xor(ssl, 16, 64); ssl += __shfl_xor(ssl, 32, 64);
          if (fq == 0) atomicAdd((float*)(ws + OFF_SS1) + row, ssl);
        }
      }
    }
  }
}

template <int MODE> DEVI void gemm_tiles_grouped(const Params& p, int t, int nM, int nN) {
  constexpr int WGM = 8;
  const int nig = WGM * nN, gid = t / nig, fm = gid * WGM, gsz = min(nM - fm, WGM);
  const int pm = fm + ((t % nig) % gsz), pn = (t % nig) / gsz;
  gemm_tile<MODE>(p, pm, pn);
}

DEVI void phase_gemm1(const Params& p) {
  constexpr int NZ = 192 * 11, NT = NZ + 2 * 48;
  for (int it = 0;; ++it) {
    const int t = remap_tile(it); if (it * (int)gridDim.x >= NT) break; if (t >= NT) continue;
    if (t < NZ) gemm_tiles_grouped<G_Z0>(p, t, 192, 11);
    else { const int u = t - NZ; if (u < 48) gemm_tile<G_MKV0>(p, u % 12, u / 12); else gemm_tile<G_MKV1>(p, (u - 48) % 12, (u - 48) / 12); }
  }
}
template <int MODE> DEVI void phase_gemm_simple(const Params& p, int nN) {
  const int NT = 192 * nN;
  for (int it = 0;; ++it) {
    const int t = remap_tile(it); if (it * (int)gridDim.x >= NT) break; if (t >= NT) continue;
    gemm_tiles_grouped<MODE>(p, t, 192, nN);
  }
}

DEVI int swz128(int row, int ch) { return row * 128 + ((ch ^ ((row >> 1) & 7)) << 4); }

template <int KDIM, int NB>
DEVI void small_gemm(const bf16* __restrict__ A  , int lda, const bf16* __restrict__ W  ,
                     f32x16 (&acc)[NB], float& ssrow, int tid) {
  constexpr int NC = KDIM / 64, WPT = NB * 32 * 8 / 512;
  const int wid = tid >> 6, lane = tid & 63, r32 = lane & 31, hi = lane >> 5;
  char* lds = g_smem;
  int aoff[4], woff[WPT];
#pragma unroll
  for (int i_ = 0; i_ < 4; ++i_) { const int q_ = tid + 512 * i_, row_ = q_ >> 3, ch_ = (q_ & 7) ^ ((row_ >> 1) & 7); aoff[i_] = row_ * lda + ch_ * 8; }
#pragma unroll
  for (int i_ = 0; i_ < WPT; ++i_) { const int q_ = tid + 512 * i_, row_ = q_ >> 3, ch_ = (q_ & 7) ^ ((row_ >> 1) & 7); woff[i_] = row_ * KDIM + ch_ * 8; }
#define SG_LOAD(b, c) do { const bf16* ag_ = A + (c) * 64; const bf16* wg_ = W + (c) * 64;                                     \
    _Pragma("unroll") for (int i_ = 0; i_ < 4; ++i_)                                                                           \
      __builtin_amdgcn_global_load_lds((const unsigned*)(ag_ + aoff[i_]), (unsigned*)(lds + (b) * 32768 + (tid + 512 * i_) * 16), 16, 0, 0); \
    _Pragma("unroll") for (int i_ = 0; i_ < WPT; ++i_)                                                                         \
      __builtin_amdgcn_global_load_lds((const unsigned*)(wg_ + woff[i_]), (unsigned*)(lds + 65536 + (b) * 32768 + (tid + 512 * i_) * 16), 16, 0, 0); } while (0)
#pragma unroll
  for (int nb = 0; nb < NB; ++nb) acc[nb] = f32x16{};
  float ss = 0.f;
  __syncthreads();
  SG_LOAD(0, 0); asm volatile("s_waitcnt vmcnt(0)" ::: "memory"); __syncthreads();
#pragma unroll 1
  for (int c = 0; c < NC; ++c) {
    const int b = c & 1;
    if (c + 1 < NC) SG_LOAD(b ^ 1, c + 1);
#pragma unroll
    for (int ks = 0; ks < 4; ++ks) {
      const int ch = ks * 2 + hi;
      const bf16x8 a = *reinterpret_cast<const bf16x8*>(lds + b * 32768 + swz128(wid * 32 + r32, ch));
      const u32x4 au = __builtin_bit_cast(u32x4, a);
#pragma unroll
      for (int j = 0; j < 4; ++j) { const float lo = bflo(au[j]), h2 = bfhi(au[j]); ss += lo * lo + h2 * h2; }
#pragma unroll
      for (int nb = 0; nb < NB; ++nb) {
        const bf16x8 w = *reinterpret_cast<const bf16x8*>(lds + 65536 + b * 32768 + swz128(nb * 32 + r32, ch));
        acc[nb] = __builtin_amdgcn_mfma_f32_32x32x16_bf16(w, a, acc[nb], 0, 0, 0);
      }
      SBAR();
    }
    asm volatile("s_waitcnt vmcnt(0)" ::: "memory"); __syncthreads();
  }
  ssrow = swap_sum(ss);
#undef SG_LOAD
}

DEVI void rope_pair(f32x16& x1, f32x16& x2, const float* __restrict__ rc, const float* __restrict__ rs, int pos, int hi) {
#pragma unroll
  for (int g = 0; g < 4; ++g) {
    const f32x4 c = *reinterpret_cast<const f32x4*>(rc + pos * 32 + 8 * g + 4 * hi);
    const f32x4 s = *reinterpret_cast<const f32x4*>(rs + pos * 32 + 8 * g + 4 * hi);
#pragma unroll
    for (int j = 0; j < 4; ++j) { const float a = x1[4 * g + j], b = x2[4 * g + j]; x1[4 * g + j] = a * c[j] - b * s[j]; x2[4 * g + j] = b * c[j] + a * s[j]; }
  }
}
DEVI void store_blk(bf16* __restrict__ dst  , const f32x16& v, int hi) {
  bf16x8 o0, o1; PK4(v, 0, o0); PK4(v, 8, o1);
  *reinterpret_cast<bf16x8*>(dst + hi * 8) = o0; *reinterpret_cast<bf16x8*>(dst + 16 + hi * 8) = o1;
}

DEVI void scale_gain_blk(f32x16& v, const f32x16& a, float f, const float* __restrict__ gain  , int hi) {
#pragma unroll
  for (int g = 0; g < 4; ++g) {
    const f32x4 gn = *reinterpret_cast<const f32x4*>(gain + 8 * g + 4 * hi);
#pragma unroll
    for (int j = 0; j < 4; ++j) v[4 * g + j] = a[4 * g + j] * (f * gn[j]);
  }
}
DEVI void gain_inplace(f32x16& v, float f, const float* __restrict__ gain, int hi) {
  float gs[32];
  cfloat_p cg = (cfloat_p)(uintptr_t)gain;
#pragma unroll
  for (int i = 0; i < 32; ++i) gs[i] = cg[i];
#pragma unroll
  for (int g = 0; g < 4; ++g)
#pragma unroll
    for (int j = 0; j < 4; ++j) v[4 * g + j] *= f * (hi ? gs[8 * g + 4 + j] : gs[8 * g + j]);
}
DEVI void rope_cs(int pos, int i, float& c, float& s) {
  const float inv = __builtin_amdgcn_exp2f(-(float)i * (13.287712379549449f / 32.f)) * 0.15915494309189535f;
  float rev = (float)pos * inv; rev -= floorf(rev);
  c = __builtin_amdgcn_cosf(rev); s = __builtin_amdgcn_sinf(rev);
}
DEVI void rope_inplace(f32x16& x1, f32x16& x2, int pos, int hi) {
#pragma unroll
  for (int g = 0; g < 4; ++g)
#pragma unroll
    for (int j = 0; j < 4; ++j) { float c, s; rope_cs(pos, 8 * g + 4 * hi + j, c, s);
      const float a = x1[4 * g + j], b = x2[4 * g + j]; x1[4 * g + j] = a * c - b * s; x2[4 * g + j] = b * c + a * s; }
}
DEVI void p2_epi_q(const Params& p, f32x16 (&acc)[6], float rs, int tok, int h, int hi) {
  char* ws = p.ws; LAUNDER_PTR(ws);
  float hs = 0.f;
#pragma unroll
  for (int nb = 0; nb < 6; ++nb)
#pragma unroll
    for (int r = 0; r < 16; ++r) hs += acc[nb][r] * acc[nb][r];
  hs = swap_sum(hs) * rs * rs;
  const float f = rs * rsqrtf(hs * (1.f / 192.f) + EPS) * (0.07216878364870322f * LOG2E);
  const int pos = tok & (SEQ - 1);
  bf16* dst = (bf16*)(ws + OFF_Q0) + (size_t)tok * 1536 + h * 192;
  SBAR();
  gain_inplace(acc[4], f, p.a_q_norm + 128, hi); gain_inplace(acc[5], f, p.a_q_norm + 160, hi);
  rope_inplace(acc[4], acc[5], pos, hi);
  store_blk(dst + 128, acc[4], hi); SBAR(); store_blk(dst + 160, acc[5], hi); SBAR();
#pragma unroll
  for (int nb = 0; nb < 4; ++nb) { gain_inplace(acc[nb], f, p.a_q_norm + nb * 32, hi); store_blk(dst + nb * 32, acc[nb], hi); SBAR(); }
}
DEVI void p2_epi_k(const Params& p, f32x16 (&acc)[4], float rs, int tok, int h, int hi, const u32x2 (&kra)[4], const u32x2 (&krb)[4], float kq) {
  char* ws = p.ws; LAUNDER_PTR(ws);
  const int pos = tok & (SEQ - 1);
  float ks = 0.f;
#pragma unroll
  for (int nb = 0; nb < 4; ++nb)
#pragma unroll
    for (int r = 0; r < 16; ++r) ks += acc[nb][r] * acc[nb][r];
  ks = swap_sum(ks * rs * rs + kq);
  const float rk = rsqrtf(ks * (1.f / 192.f) + EPS);
  bf16* kd = (bf16*)(ws + OFF_K0) + (size_t)tok * 1536 + h * 192;
  SBAR();
  float g1s[32], g2s[32];
  { cfloat_p ck = (cfloat_p)(uintptr_t)p.a_k_norm;
#pragma unroll
    for (int i = 0; i < 32; ++i) { g1s[i] = ck[128 + i]; g2s[i] = ck[160 + i]; } }
#pragma unroll
  for (int hf = 0; hf < 2; ++hf) {
    float x1[8], x2[8];
#pragma unroll
    for (int gg = 0; gg < 2; ++gg) {
      const int g = 2 * hf + gg;
      const u32x2 a = kra[g], b = krb[g];
      const float av[4] = {bflo(a[0]), bfhi(a[0]), bflo(a[1]), bfhi(a[1])}, bv[4] = {bflo(b[0]), bfhi(b[0]), bflo(b[1]), bfhi(b[1])};
#pragma unroll
      for (int j = 0; j < 4; ++j) { float c, sn; rope_cs(pos, 8 * g + 4 * hi + j, c, sn);
        const float u = av[j] * rk * (hi ? g1s[8 * g + 4 + j] : g1s[8 * g + j]), w = bv[j] * rk * (hi ? g2s[8 * g + 4 + j] : g2s[8 * g + j]);
        x1[4 * gg + j] = u * c - w * sn; x2[4 * gg + j] = w * c + u * sn; }
    }
    bf16x8 o1, o2; PK4(x1, 0, o1); PK4(x2, 0, o2);
    *reinterpret_cast<bf16x8*>(kd + 128 + hf * 16 + hi * 8) = o1; *reinterpret_cast<bf16x8*>(kd + 160 + hf * 16 + hi * 8) = o2;
  }
#pragma unroll
  for (int nb = 0; nb < 4; ++nb) { gain_inplace(acc[nb], rs * rk, p.a_k_norm + nb * 32, hi); store_blk(kd + nb * 32, acc[nb], hi); SBAR(); }
}
DEVI void p2_epi_v(const Params& p, f32x16 (&acc)[4], float rs, int tok, int h, int hi) {
  char* ws = p.ws; LAUNDER_PTR(ws);
  bf16* vd = (bf16*)(ws + OFF_V0) + (size_t)tok * 1024 + h * 128;
#pragma unroll
  for (int nb = 0; nb < 4; ++nb) {
#pragma unroll
    for (int r = 0; r < 16; ++r) acc[nb][r] *= rs;
    store_blk(vd + nb * 32, acc[nb], hi); SBAR();
  }
}

template <bool ISQ>
DEVI void p2_job(const Params& p, int mt, int half) {
  constexpr int KDIM = ISQ ? 384 : 256, NFR = KDIM / 16, NB = ISQ ? 6 : 4, NC = KDIM / 64, NPART = ISQ ? 4 : 8;
  constexpr int ROWS = NB * 32, LPC = ROWS * 8 / 512, STG = ROWS * 128, NSTG = ISQ ? 4 : 5, DEPTH = NSTG - 1;
  constexpr int NFH = ISQ ? NFR - 4 : NFR;
  char* ws = p.ws; LAUNDER_PTR(ws); char* lds = g_smem;
  LAUNDER_TID(tid); const int wid = tid >> 6, lane = tid & 63, r32 = lane & 31, hi = lane >> 5;
  const int tok = mt * 256 + wid * 32 + r32;
  const bf16* Wb = ISQ ? (const bf16*)(ws + OFF_WQ) + (size_t)(half * 4) * 192 * 384 : (const bf16*)(ws + OFF_WKV) + (size_t)(half * 4) * 256 * 256;
  int ip = 0, ic = 0, si = 0;
#define P2_ISSUE() do { const bf16* wg_ = Wb + (size_t)ip * (ROWS * KDIM) + ic * 64; const unsigned woff0 = (tid >> 3) * KDIM + (((tid & 7) ^ ((tid >> 4) & 7)) * 8); \
    _Pragma("unroll") for (int i_ = 0; i_ < LPC; ++i_)                                                                          \
      __builtin_amdgcn_global_load_lds((const unsigned*)((wg_ + i_ * 64 * KDIM) + woff0), (unsigned*)(lds + si * STG + (tid + 512 * i_) * 16), 16, 0, 0); \
    si = (si == NSTG - 1) ? 0 : si + 1;                                                                                         \
    if (!(ip == NPART - 1 && ic == NC - 1)) { if (++ic == NC) { ic = 0; ++ip; } } } while (0)
  const bf16* arow = (const bf16*)(ws + OFF_ZA) + (size_t)tok * 704 + (ISQ ? 0 : 384) + hi * 8;
  float ss = 0.f;
#pragma unroll
  for (int f = 0; f < NFR; ++f) { const u32x4 au = *reinterpret_cast<const u32x4*>(arow + f * 16);
#pragma unroll
    for (int j = 0; j < 4; ++j) { const float lo = bflo(au[j]), h2 = bfhi(au[j]); ss += lo * lo + h2 * h2; } }
  const float rs = rsqrtf(swap_sum(ss) * (1.f / KDIM) + EPS);
  asm volatile("" ::: "memory"); SBAR();
  __syncthreads();
  P2_ISSUE(); P2_ISSUE(); P2_ISSUE(); if constexpr (DEPTH == 4) P2_ISSUE();
  SBAR();
  bf16x8 af[NFH];
#pragma unroll
  for (int f = 0; f < NFH; ++f) af[f] = *reinterpret_cast<const bf16x8*>(arow + f * 16);
  char* apark = lds + NSTG * STG + wid * 4096 + lane * 16;
  if constexpr (ISQ) {
#pragma unroll
    for (int f = 0; f < 4; ++f) { const bf16x8 t = *reinterpret_cast<const bf16x8*>(arow + (NFH + f) * 16); *reinterpret_cast<bf16x8*>(apark + f * 1024) = t; }
  }
  asm volatile("s_waitcnt vmcnt(0)" ::: "memory");
  u32x2 kra[4] = {}, krb[4] = {}; float kq = 0.f;
  if constexpr (!ISQ) {
    const bf16* kr = (const bf16*)(ws + OFF_ZA) + (size_t)tok * 704 + 640;
#pragma unroll
    for (int g = 0; g < 4; ++g) { kra[g] = *reinterpret_cast<const u32x2*>(kr + 8 * g + 4 * hi); krb[g] = *reinterpret_cast<const u32x2*>(kr + 32 + 8 * g + 4 * hi); }
#pragma unroll
    for (int g = 0; g < 4; ++g) {
      kq += bflo(kra[g][0]) * bflo(kra[g][0]) + bfhi(kra[g][0]) * bfhi(kra[g][0]) + bflo(kra[g][1]) * bflo(kra[g][1]) + bfhi(kra[g][1]) * bfhi(kra[g][1]);
      kq += bflo(krb[g][0]) * bflo(krb[g][0]) + bfhi(krb[g][0]) * bfhi(krb[g][0]) + bflo(krb[g][1]) * bflo(krb[g][1]) + bfhi(krb[g][1]) * bfhi(krb[g][1]);
    }
  }
  int sc = 0;
#define P2_PART() do {                                                                                                           \
    _Pragma("unroll") for (int nb = 0; nb < NB; ++nb) acc[nb] = f32x16{};                                                       \
    _Pragma("unroll") for (int c = 0; c < NC; ++c) {                                                                            \
      if (c >= DEPTH) asm volatile("s_waitcnt vmcnt(%0)" :: "n"((DEPTH - 1) * LPC) : "memory");                                  \
      __builtin_amdgcn_s_barrier();                                                                                              \
      P2_ISSUE();                                                                                                                \
      const char* wl = lds + sc * STG;                                                                                           \
      _Pragma("unroll") for (int ks = 0; ks < 4; ++ks) {                                                                        \
        const int ch = ks * 2 + hi; bf16x8 afl = {};                                                                             \
        if (c * 4 + ks >= NFH) afl = *reinterpret_cast<const bf16x8*>(apark + (c * 4 + ks - NFH) * 1024);                        \
        _Pragma("unroll") for (int nb = 0; nb < NB; ++nb) {                                                                     \
          const bf16x8 w = *reinterpret_cast<const bf16x8*>(wl + swz128(nb * 32 + r32, ch));                                     \
          acc[nb] = __builtin_amdgcn_mfma_f32_32x32x16_bf16(w, (c * 4 + ks < NFH) ? af[(c * 4 + ks < NFH) ? c * 4 + ks : 0] : afl, acc[nb], 0, 0, 0); \
          if (NB == 6 && nb == 2) SBAR();                                                                                        \
        }                                                                                                                        \
        SBAR();                                                                                                                  \
      }                                                                                                                          \
      sc = (sc == NSTG - 1) ? 0 : sc + 1;                                                                                        \
    } } while (0)
#pragma unroll 1
  for (int pi = 0; pi < NPART; ++pi) {
    f32x16 acc[NB];
    P2_PART();
    asm volatile("s_waitcnt vmcnt(0)" ::: "memory");
    { LAUNDER_TID(t2); const int tok2 = mt * 256 + (t2 >> 6) * 32 + (t2 & 31), hi2 = (t2 >> 5) & 1;
      if constexpr (ISQ) p2_epi_q(p, acc, rs, tok2, half * 4 + pi, hi2);
      else { if (pi & 1) p2_epi_v(p, acc, rs, tok2, half * 4 + (pi >> 1), hi2); else p2_epi_k(p, acc, rs, tok2, half * 4 + (pi >> 1), hi2, kra, krb, kq); } }
  }
  asm volatile("s_waitcnt vmcnt(0)" ::: "memory");
#undef P2_PART
#undef P2_ISSUE
}

DEVI void phase_p2(const Params& p) {
  constexpr int NJ = 768;
  for (int it = 0;; ++it) {
    const int t = remap_tile(it); if (it * (int)gridDim.x >= NJ) break; if (t >= NJ) continue;
    const int mt = t >> 2, sub = t & 3;
    if (sub < 2) p2_job<true>(p, mt, sub); else p2_job<false>(p, mt, sub - 2);
  }
  char* ws = p.ws; LAUNDER_TID(tid);
  const int wid = tid >> 6, lane = tid & 63, nw = gridDim.x * 8;
  for (int r = blockIdx.x * 8 + wid; r < 2 * NMEMROW; r += nw) {
    const int l = r / NMEMROW, row = r % NMEMROW;
    bf16* kp = (bf16*)(ws + OFF_MEMKV + (size_t)l * MEMKV_BYTES) + (size_t)row * 1024;
    const float* gn = p.mem_k_norm + l * 128;
    {
      const int col = lane * 8;
      const u32x4 w = *reinterpret_cast<const u32x4*>(kp + col);
      float v[8]; float ss = 0.f;
#pragma unroll
      for (int j = 0; j < 4; ++j) { v[2 * j] = bflo(w[j]); v[2 * j + 1] = bfhi(w[j]); ss += v[2 * j] * v[2 * j] + v[2 * j + 1] * v[2 * j + 1]; }
      ss += __shfl_xor(ss, 1, 64); ss += __shfl_xor(ss, 2, 64); ss += __shfl_xor(ss, 4, 64); ss += __shfl_xor(ss, 8, 64);
      const float rr = rsqrtf(ss * (1.f / 128.f) + EPS);
      const int d = col & 127;
#pragma unroll
      for (int j = 0; j < 8; ++j) v[j] *= rr * gn[d + j];
      *reinterpret_cast<u32x4*>(kp + col) = u32x4{cvtpk(v[0], v[1]), cvtpk(v[2], v[3]), cvtpk(v[4], v[5]), cvtpk(v[6], v[7])};
    }
  }
}

constexpr int KVBLK = 64;
constexpr float THR = 8.f;
template <int DQK> DEVI int kswz(int row, int colB) {
  if constexpr (DQK == 128) return row * 256 + (colB ^ ((row & 7) << 4));
  else return row * 384 + (colB ^ (((row >> 1) & 7) << 4));
}
DEVI int v_st(int k, int c) { const int kk = (k & ~0xC) | ((k & 4) << 1) | ((k & 8) >> 1); return ((kk >> 3) * 4 + (c >> 5)) * 512 + ((kk & 7) * 32 + (c & 31)) * 2; }
DEVI int v_rd_base(int lane) { return ((lane & 3) << 3) | (((lane >> 2) & 3) << 6) | (((lane >> 4) & 1) << 5) | (((lane >> 5) & 1) << 8); }
constexpr int v_rd_off(int d0, int ks, int half) { return d0 * 512 + ks * 4096 + half * 2048; }
template <int OFF> DEVI s16x4 tr_read(int vb) { s16x4 r; asm volatile("ds_read_b64_tr_b16 %0, %1 offset:%2" : "=&v"(r) : "v"(vb), "i"(OFF) : "memory"); return r; }
template <int D0> DEVI void pv_one(f32x16& od, int vb, bf16x8 pa0, bf16x8 pa1, bf16x8 pa2, bf16x8 pa3) {
  const s16x4 l0 = tr_read<v_rd_off(D0, 0, 0)>(vb), h0 = tr_read<v_rd_off(D0, 0, 1)>(vb), l1 = tr_read<v_rd_off(D0, 1, 0)>(vb), h1 = tr_read<v_rd_off(D0, 1, 1)>(vb);
  const s16x4 l2 = tr_read<v_rd_off(D0, 2, 0)>(vb), h2 = tr_read<v_rd_off(D0, 2, 1)>(vb), l3 = tr_read<v_rd_off(D0, 3, 0)>(vb), h3 = tr_read<v_rd_off(D0, 3, 1)>(vb);
  asm volatile("s_waitcnt lgkmcnt(0)" ::: "memory"); SBAR();
#define PKV(L, H) (bf16x8){L[0], L[1], L[2], L[3], H[0], H[1], H[2], H[3]}
  od = __builtin_amdgcn_mfma_f32_32x32x16_bf16(pa0, PKV(l0, h0), od, 0, 0, 0);
  od = __builtin_amdgcn_mfma_f32_32x32x16_bf16(pa1, PKV(l1, h1), od, 0, 0, 0);
  od = __builtin_amdgcn_mfma_f32_32x32x16_bf16(pa2, PKV(l2, h2), od, 0, 0, 0);
  od = __builtin_amdgcn_mfma_f32_32x32x16_bf16(pa3, PKV(l3, h3), od, 0, 0, 0);
#undef PKV
}
DEVI void pv_d0(f32x16* o, int vb, bf16x8 pa0, bf16x8 pa1, bf16x8 pa2, bf16x8 pa3) {
  pv_one<0>(o[0], vb, pa0, pa1, pa2, pa3); pv_one<1>(o[1], vb, pa0, pa1, pa2, pa3); pv_one<2>(o[2], vb, pa0, pa1, pa2, pa3); pv_one<3>(o[3], vb, pa0, pa1, pa2, pa3);
}
template <int DQK> DEVI void partialSM(f32x16& p0, f32x16& p1, float& m_reg, float& mn, float& alpha) {
  constexpr float SCALE = (DQK == 192) ? 0.07216878364870322f : 0.08838834764831845f;
  constexpr float C = SCALE * LOG2E;
  float pmax = p0[0];
#pragma unroll
  for (int r = 1; r < 16; ++r) pmax = fmaxf(pmax, p0[r]);
#pragma unroll
  for (int r = 0; r < 16; ++r) pmax = fmaxf(pmax, p1[r]);
  pmax = swap_max(pmax);
  if (__builtin_expect(__all(pmax - m_reg <= THR / SCALE), 1)) { mn = m_reg; alpha = 1.f; }
  else { mn = fmaxf(m_reg, pmax); alpha = __builtin_amdgcn_exp2f((m_reg - mn) * C); m_reg = mn; }
  const float mnC = -mn * C;
#pragma unroll
  for (int r = 0; r < 16; ++r) p0[r] = fmaf(p0[r], C, mnC);
#pragma unroll
  for (int r = 0; r < 16; ++r) p1[r] = fmaf(p1[r], C, mnC);
#pragma unroll
  for (int r = 0; r < 16; ++r) p0[r] = __builtin_amdgcn_exp2f(p0[r]);
}
DEVI void finishSM(f32x16& p0, f32x16& p1, float alpha, float& l_reg, bf16x8& pa0, bf16x8& pa1, bf16x8& pa2, bf16x8& pa3) {
#pragma unroll
  for (int r = 0; r < 16; ++r) p1[r] = __builtin_amdgcn_exp2f(p1[r]);
  float ps = 0;
#pragma unroll
  for (int r = 0; r < 16; ++r) ps += p0[r];
#pragma unroll
  for (int r = 0; r < 16; ++r) ps += p1[r];
  ps = swap_sum(ps);
  l_reg = l_reg * alpha + ps;
  PK4(p0, 0, pa0); PK4(p0, 8, pa1); PK4(p1, 0, pa2); PK4(p1, 8, pa3);
}
template <int DQK> DEVI void qkt_acc(f32x16& p0, f32x16& p1, const char* Ks, const bf16x8* qr, int r32, int hi) {
#pragma unroll
  for (int d0 = 0; d0 < DQK / 16; ++d0) { const int cb = (d0 * 16 + hi * 8) * 2;
    const bf16x8 b0 = *reinterpret_cast<const bf16x8*>(Ks + kswz<DQK>(r32, cb));
    const bf16x8 b1 = *reinterpret_cast<const bf16x8*>(Ks + kswz<DQK>(32 + r32, cb));
    p0 = __builtin_amdgcn_mfma_f32_32x32x16_bf16(b0, qr[d0], p0, 0, 0, 0);
    p1 = __builtin_amdgcn_mfma_f32_32x32x16_bf16(b1, qr[d0], p1, 0, 0, 0); }
}
DEVI float silu_f(float g) { return g * __builtin_amdgcn_rcpf(1.f + __builtin_amdgcn_exp2f(-g * LOG2E)); }

template <int DQK, bool QNORM>
DEVI void attn_dense(const bf16* __restrict__ Qb, int ldq, const bf16* __restrict__ Kh, int ldk, const bf16* __restrict__ Vh, int ldv,
                     const bf16* __restrict__ Gb, int ldg, bf16* __restrict__ Ob, int ldo, int seq, const float* __restrict__ qgain, float negM) {
  constexpr int ND0 = DQK / 16, NCH = DQK / 8, KPT = NCH / 8;
  constexpr int SHM_V = 16384, SHM_K = 64 * DQK * 2;
  char* lds = g_smem;
  LAUNDER_TID(tid); const int wid = tid >> 6, lane = tid & 63, r32 = lane & 31, hi = lane >> 5;
  char* V_lds = lds; char* K_lds = lds + 2 * SHM_V;
  float* wsf = (float*)(lds + 2 * SHM_V + 2 * SHM_K) + wid * 64; float* li_l = wsf; float* al_l = wsf + 32;
  float l_reg = 0; f32x16 o[4] = {}; bf16x8 qr[ND0];
  const bf16* Qw = Qb + (size_t)(wid * 32 + r32) * ldq + hi * 8;
#pragma unroll
  for (int d0 = 0; d0 < ND0; ++d0) qr[d0] = *reinterpret_cast<const bf16x8*>(Qw + d0 * 16);
  if constexpr (QNORM) {
    float ss = 0.f;
#pragma unroll
    for (int d0 = 0; d0 < ND0; ++d0) { const u32x4 u = __builtin_bit_cast(u32x4, qr[d0]);
#pragma unroll
      for (int j = 0; j < 4; ++j) { const float a = bflo(u[j]), b = bfhi(u[j]); ss += a * a + b * b; } }
    ss = swap_sum(ss);
    const float rq = rsqrtf(ss * (1.f / DQK) + EPS) * (0.08838834764831845f * LOG2E);
#pragma unroll
    for (int d0 = 0; d0 < ND0; ++d0) { const u32x4 u = __builtin_bit_cast(u32x4, qr[d0]); u32x4 w;
      const f32x4 g0 = *reinterpret_cast<const f32x4*>(qgain + d0 * 16 + hi * 8), g1 = *reinterpret_cast<const f32x4*>(qgain + d0 * 16 + hi * 8 + 4);
      w[0] = cvtpk(bflo(u[0]) * rq * g0[0], bfhi(u[0]) * rq * g0[1]); w[1] = cvtpk(bflo(u[1]) * rq * g0[2], bfhi(u[1]) * rq * g0[3]);
      w[2] = cvtpk(bflo(u[2]) * rq * g1[0], bfhi(u[2]) * rq * g1[1]); w[3] = cvtpk(bflo(u[3]) * rq * g1[2], bfhi(u[3]) * rq * g1[3]);
      qr[d0] = __builtin_bit_cast(bf16x8, w); }
  }
  int kgo[KPT], vgo[2];
#pragma unroll
  for (int i = 0; i < KPT; ++i) { const int q = tid + 512 * i, row = q / NCH, chp = q % NCH;
    const int ch = (DQK == 128) ? (chp ^ (row & 7)) : (chp ^ ((row >> 1) & 7)); kgo[i] = row * ldk + ch * 8; }
#pragma unroll
  for (int i = 0; i < 2; ++i) { const int q = tid + 512 * i, st = q >> 5, kk = (st >> 2) * 8 + ((q >> 2) & 7), cc = q & 3;
    const int k = (kk & ~0xC) | ((kk & 4) << 1) | ((kk & 8) >> 1); vgo[i] = k * ldv + (st & 3) * 32 + cc * 8; }
  const int vb0 = (int)(uintptr_t)V_lds + v_rd_base(lane);
#define GLOAD(b, k0) do { const bf16* kg_ = Kh + (size_t)(k0) * ldk; const bf16* vg_ = Vh + (size_t)(k0) * ldv;               \
    _Pragma("unroll") for (int q_ = 0; q_ < KPT; ++q_) __builtin_amdgcn_global_load_lds((const unsigned*)(kg_ + kgo[q_]), (unsigned*)(K_lds + (b) * SHM_K + q_ * 8192 + tid * 16), 16, 0, 0); \
    _Pragma("unroll") for (int q_ = 0; q_ < 2; ++q_) __builtin_amdgcn_global_load_lds((const unsigned*)(vg_ + vgo[q_]), (unsigned*)(V_lds + (b) * SHM_V + q_ * 8192 + tid * 16), 16, 0, 0); } while (0)
  const int NT = seq / KVBLK;
  __syncthreads();
  GLOAD(0, 0);
  asm volatile("s_waitcnt vmcnt(0)" ::: "memory"); __syncthreads();
  for (int j = 0; j < NT; ++j) {
    const int b = j & 1;
    if (j + 1 < NT) GLOAD(b ^ 1, (j + 1) * KVBLK);
    f32x16 p0, p1; bf16x8 pa0, pa1, pa2, pa3;
#pragma unroll
    for (int r = 0; r < 16; ++r) { p0[r] = negM; p1[r] = negM; }
    qkt_acc<DQK>(p0, p1, K_lds + b * SHM_K, qr, r32, hi);
#pragma unroll
    for (int r = 0; r < 16; ++r) { p0[r] = __builtin_amdgcn_exp2f(p0[r]); p1[r] = __builtin_amdgcn_exp2f(p1[r]); }
    float ps = 0.f;
#pragma unroll
    for (int r = 0; r < 16; ++r) ps += p0[r] + p1[r];
    l_reg += ps;
    PK4(p0, 0, pa0); PK4(p0, 8, pa1); PK4(p1, 0, pa2); PK4(p1, 8, pa3);
    pv_d0(o, vb0 + b * SHM_V, pa0, pa1, pa2, pa3);
    asm volatile("s_waitcnt vmcnt(0)" ::: "memory"); __syncthreads();
  }
  l_reg = swap_sum(l_reg);
  if (hi == 0) li_l[r32] = l_reg; asm volatile("s_waitcnt lgkmcnt(0)" ::: "memory");
  const bf16* Gw = Gb + (size_t)(wid * 32) * ldg; bf16* Ow = Ob + (size_t)(wid * 32) * ldo;
#pragma unroll
  for (int r = 0; r < 16; ++r) { const int orow = crow(r, hi); const float rl = __builtin_amdgcn_rcpf(li_l[orow]);
#pragma unroll
    for (int d0 = 0; d0 < 4; ++d0) {
      const float g = __bfloat162float(Gw[(size_t)orow * ldg + d0 * 32 + r32]);
      Ow[(size_t)orow * ldo + d0 * 32 + r32] = __float2bfloat16(o[d0][r] * rl * silu_f(g));
    } }
#undef GLOAD
}

DEVI void mla_item(const Params& p, int t, float negM) {
  char* ws = p.ws; const int qb = t & 15, h = (t >> 4) & 7, b = t >> 7;
  const size_t tok0 = (size_t)b * SEQ + qb * 256, tokb = (size_t)b * SEQ;
  bf16* Q = (bf16*)(ws + OFF_Q0) + tok0 * 1536 + h * 192;
  attn_dense<192, false>(Q, 1536, (const bf16*)(ws + OFF_K0) + tokb * 1536 + h * 192, 1536, (const bf16*)(ws + OFF_V0) + tokb * 1024 + h * 128, 1024,
                         (const bf16*)p.out + tok0 * 2048 + 512 + h * 128, 2048, Q, 1536, SEQ, nullptr, negM);
}
template <int L> DEVI void mem_item(const Params& p, int t, float negM) {
  char* ws = p.ws; const int qb = t & 15, hm = (t >> 4) & 3, b = t >> 6;
  const size_t tok0 = (size_t)b * SEQ + qb * 256;
  const bf16* zb = (L == 0 ? (const bf16*)p.out : (const bf16*)(ws + OFF_Z1B)) + tok0 * 2048;
  const bf16* kv = (const bf16*)(ws + OFF_MEMKV + (size_t)L * MEMKV_BYTES) + (size_t)b * 256 * 1024 + hm * 128;
  bf16* mo = (bf16*)(ws + (L == 0 ? OFF_MEMO0 : OFF_MEMO1)) + tok0 * 512 + hm * 128;
  attn_dense<128, true>(zb + hm * 128, 2048, kv, 1024, kv + 512, 1024, zb + 512 + 1024 + hm * 128, 2048, mo, 512, 256, p.mem_q_norm + L * 128, negM);
}
DEVI float softmax_shift(const float* __restrict__ gq, const float* __restrict__ gk, int n) {
  float mq = 0.f, mk = 0.f;
  cfloat_p cq = (cfloat_p)(uintptr_t)gq, ck = (cfloat_p)(uintptr_t)gk;
  for (int i = 0; i < n; ++i) { mq = fmaxf(mq, fabsf(cq[i])); mk = fmaxf(mk, fabsf(ck[i])); }
  return -LOG2E * sqrtf((float)n) * mq * mk;
}
DEVI void phase_attn0(const Params& p) {
  const float negM_mla = softmax_shift(p.a_q_norm, p.a_k_norm, 192), negM_mem = softmax_shift(p.mem_q_norm, p.mem_k_norm, 128);
  constexpr int NJ = 1536 + 768;
  for (int it = 0;; ++it) {
    const int t = remap_tile(it); if (it * (int)gridDim.x >= NJ) break; if (t >= NJ) continue;
    if (t < 1536) mla_item(p, t, negM_mla); else mem_item<0>(p, t - 1536, negM_mem);
  }
}

DEVI void phase_knorm(const Params& p) {
  char* ws = p.ws; const bf16* z = (const bf16*)(ws + OFF_Z1A); bf16* kn = (bf16*)(ws + OFF_KN);
  LAUNDER_TID(tid);
  const long gt = (long)blockIdx.x * 512 + tid, gsz = (long)gridDim.x * 512;
  for (long i = gt; i < (long)NTOK * 16; i += gsz) {
    const long tok = i >> 4; const int c = (int)(i & 15) * 8;
    const u32x4 w = *reinterpret_cast<const u32x4*>(z + tok * 1280 + 1024 + c);
    float v[8]; float ss = 0.f;
#pragma unroll
    for (int j = 0; j < 4; ++j) { v[2 * j] = bflo(w[j]); v[2 * j + 1] = bfhi(w[j]); ss += v[2 * j] * v[2 * j] + v[2 * j + 1] * v[2 * j + 1]; }
    ss += __shfl_xor(ss, 1, 64); ss += __shfl_xor(ss, 2, 64); ss += __shfl_xor(ss, 4, 64);
    const float rr = rsqrtf(ss * (1.f / 64.f) + EPS);
    const int d = c & 63;
#pragma unroll
    for (int j = 0; j < 8; ++j) v[j] *= rr * p.b_k_norm[d + j];
    *reinterpret_cast<u32x4*>(kn + tok * 128 + c) = u32x4{cvtpk(v[0], v[1]), cvtpk(v[2], v[3]), cvtpk(v[4], v[5]), cvtpk(v[6], v[7])};
  }
}

constexpr int v_rd_off64(int d0, int ks, int half) { return ((2 * ks + half) * 2 + d0) * 512; }
template <int KS> DEVI void pv_ks64(f32x16* o, int vb, bf16x8 pa) {
  const s16x4 l0 = tr_read<v_rd_off64(0, KS, 0)>(vb), h0 = tr_read<v_rd_off64(0, KS, 1)>(vb), l1 = tr_read<v_rd_off64(1, KS, 0)>(vb), h1 = tr_read<v_rd_off64(1, KS, 1)>(vb);
  asm volatile("s_waitcnt lgkmcnt(0)" ::: "memory"); SBAR();
#define PKV(L, H) (bf16x8){L[0], L[1], L[2], L[3], H[0], H[1], H[2], H[3]}
  o[0] = __builtin_amdgcn_mfma_f32_32x32x16_bf16(pa, PKV(l0, h0), o[0], 0, 0, 0);
  o[1] = __builtin_amdgcn_mfma_f32_32x32x16_bf16(pa, PKV(l1, h1), o[1], 0, 0, 0);
#undef PKV
}
DEVI void swa_item(const Params& p, int t, float bound2) {
  char* ws = p.ws; LAUNDER_PTR(ws); char* lds = g_smem;
  const int qc = t & 127, kvh = (t >> 7) & 1, b = t >> 8;
  LAUNDER_TID(tid); const int wid = tid >> 6, lane = tid & 63, r32 = lane & 31, hi = lane >> 5;
  const int hq = kvh * 8 + wid, i0 = qc * 32; const size_t tokb = (size_t)b * SEQ;
  bf16* z1a = (bf16*)(ws + OFF_Z1A); const bf16* kn = (const bf16*)(ws + OFF_KN); const bf16* z1b = (const bf16*)(ws + OFF_Z1B);
  char* K_lds = lds; char* V_lds = lds + 5 * 8192; float* li_l = (float*)(lds + 10 * 8192) + wid * 64;
  const int ts0 = (i0 - 128) & ~63;
  const int jlo = ts0 < 0 ? (-ts0) >> 6 : 0, jhi = min(5, (SEQ - ts0) >> 6);
  __syncthreads();
  {
    const int krow = tid >> 3, kch = (tid & 7) ^ ((krow >> 1) & 7);
    const int st = tid >> 5, kk = (st >> 1) * 8 + ((tid >> 2) & 7), vk = (kk & ~0xC) | ((kk & 4) << 1) | ((kk & 8) >> 1), vcol = (st & 1) * 32 + (tid & 3) * 8;
    const bf16* kg = kn + (tokb + ts0 + krow) * 128 + kvh * 64 + kch * 8;
    const bf16* vg = z1a + (tokb + ts0 + vk) * 1280 + 1152 + kvh * 64 + vcol;
    for (int j = jlo; j < jhi; ++j) {
      __builtin_amdgcn_global_load_lds((const unsigned*)(kg + (size_t)j * 64 * 128), (unsigned*)(K_lds + j * 8192 + tid * 16), 16, 0, 0);
      __builtin_amdgcn_global_load_lds((const unsigned*)(vg + (size_t)j * 64 * 1280), (unsigned*)(V_lds + j * 8192 + tid * 16), 16, 0, 0);
    }
  }
  const bf16* Gw = z1b + (tokb + i0) * 2048 + 512 + hq * 64 + r32;
  unsigned gpk[16];
#pragma unroll
  for (int r = 0; r < 16; ++r) { const int orow = crow(r, hi);
    const unsigned g0 = *reinterpret_cast<const unsigned short*>(Gw + (size_t)orow * 2048), g1 = *reinterpret_cast<const unsigned short*>(Gw + (size_t)orow * 2048 + 32);
    gpk[r] = g0 | (g1 << 16); }
  bf16* Qw = z1a + (tokb + i0 + r32) * 1280 + hq * 64;
  bf16x8 qr[4];
  { float ss = 0.f; u32x4 u[4];
#pragma unroll
    for (int d0 = 0; d0 < 4; ++d0) { u[d0] = *reinterpret_cast<const u32x4*>(Qw + d0 * 16 + hi * 8);
#pragma unroll
      for (int j = 0; j < 4; ++j) { const float a = bflo(u[d0][j]), c = bfhi(u[d0][j]); ss += a * a + c * c; } }
    ss = swap_sum(ss);
    const float rq = rsqrtf(ss * (1.f / 64.f) + EPS) * (0.125f * LOG2E);
#pragma unroll
    for (int d0 = 0; d0 < 4; ++d0) { u32x4 w;
      const f32x4 g0 = *reinterpret_cast<const f32x4*>(p.b_q_norm + d0 * 16 + hi * 8), g1 = *reinterpret_cast<const f32x4*>(p.b_q_norm + d0 * 16 + hi * 8 + 4);
      w[0] = cvtpk(bflo(u[d0][0]) * rq * g0[0], bfhi(u[d0][0]) * rq * g0[1]); w[1] = cvtpk(bflo(u[d0][1]) * rq * g0[2], bfhi(u[d0][1]) * rq * g0[3]);
      w[2] = cvtpk(bflo(u[d0][2]) * rq * g1[0], bfhi(u[d0][2]) * rq * g1[1]); w[3] = cvtpk(bflo(u[d0][3]) * rq * g1[2], bfhi(u[d0][3]) * rq * g1[3]);
      qr[d0] = __builtin_bit_cast(bf16x8, w); }
  }
  const float slope2 = exp2f(-0.5f * (float)(hq + 1)) * LOG2E, sink2 = p.b_sink[hq] * LOG2E;
  const float negM = -fmaxf(bound2, sink2);
  float l_reg = 0.f;
  f32x16 o[2] = {};
  const int vb0 = (int)(uintptr_t)V_lds + v_rd_base(lane);
  const int query = i0 + r32;
  asm volatile("s_waitcnt vmcnt(0)" ::: "memory"); __syncthreads();
  for (int j = jlo; j < jhi; ++j) {
    const int ts = ts0 + 64 * j; const char* Kt = K_lds + j * 8192;
    f32x16 p0, p1;
#pragma unroll
    for (int r = 0; r < 16; ++r) { p0[r] = negM; p1[r] = negM; }
#pragma unroll
    for (int d0 = 0; d0 < 4; ++d0) { const int ch = d0 * 2 + hi;
      const bf16x8 b0 = *reinterpret_cast<const bf16x8*>(Kt + swz128(r32, ch));
      const bf16x8 b1 = *reinterpret_cast<const bf16x8*>(Kt + swz128(32 + r32, ch));
      p0 = __builtin_amdgcn_mfma_f32_32x32x16_bf16(b0, qr[d0], p0, 0, 0, 0);
      p1 = __builtin_amdgcn_mfma_f32_32x32x16_bf16(b1, qr[d0], p1, 0, 0, 0); }
    const float fb0 = (float)(ts - query + 4 * hi), fb1 = fb0 + 32.f;
    const bool full = (ts - (i0 + 31) >= -128) && (ts + 63 - i0 <= 128);
    float ps = 0.f;
    if (full) {
#pragma unroll
      for (int r = 0; r < 16; ++r) { const float off = (float)((r & 3) + 8 * (r >> 2));
        p0[r] = __builtin_amdgcn_exp2f(fmaf(-slope2, fabsf(fb0 + off), p0[r]));
        p1[r] = __builtin_amdgcn_exp2f(fmaf(-slope2, fabsf(fb1 + off), p1[r]));
        ps += p0[r] + p1[r]; }
    } else {
#pragma unroll
      for (int r = 0; r < 16; ++r) { const float off = (float)((r & 3) + 8 * (r >> 2));
        const float e0 = fabsf(fb0 + off), e1 = fabsf(fb1 + off);
        p0[r] = e0 <= 128.f ? __builtin_amdgcn_exp2f(fmaf(-slope2, e0, p0[r])) : 0.f;
        p1[r] = e1 <= 128.f ? __builtin_amdgcn_exp2f(fmaf(-slope2, e1, p1[r])) : 0.f;
        ps += p0[r] + p1[r]; }
    }
    l_reg += ps;
    const int vb = vb0 + j * 8192; bf16x8 pa;
    PK4(p0, 0, pa); pv_ks64<0>(o, vb, pa); PK4(p0, 8, pa); pv_ks64<1>(o, vb, pa);
    PK4(p1, 0, pa); pv_ks64<2>(o, vb, pa); PK4(p1, 8, pa); pv_ks64<3>(o, vb, pa);
  }
  l_reg = swap_sum(l_reg) + __builtin_amdgcn_exp2f(sink2 + negM);
  if (hi == 0) li_l[r32] = l_reg; asm volatile("s_waitcnt lgkmcnt(0)" ::: "memory");
  bf16* Ow = z1a + (tokb + i0) * 1280 + hq * 64 + r32;
#pragma unroll
  for (int r = 0; r < 16; ++r) { const int orow = crow(r, hi); const float rl = __builtin_amdgcn_rcpf(li_l[orow]);
    Ow[(size_t)orow * 1280] = __float2bfloat16(o[0][r] * rl * silu_f(bflo(gpk[r])));
    Ow[(size_t)orow * 1280 + 32] = __float2bfloat16(o[1][r] * rl * silu_f(bfhi(gpk[r])));
  }
}
DEVI void phase_attn1(const Params& p) {
  const float negM_mem = softmax_shift(p.mem_q_norm + 128, p.mem_k_norm + 128, 128), bound2_swa = -softmax_shift(p.b_q_norm, p.b_k_norm, 64);
  constexpr int NJ = 3072 + 768;
  for (int it = 0;; ++it) {
    const int t = remap_tile(it); if (it * (int)gridDim.x >= NJ) break; if (t >= NJ) continue;
    if (t < 768) mem_item<1>(p, t, negM_mem); else swa_item(p, t - 768, bound2_swa);
  }
}

template <int PH> DEVI void run_phase(const Params& p) {
  if constexpr (PH == 0) phase_prep(p);
  else if constexpr (PH == 1) phase_gemm1(p);
  else if constexpr (PH == 2) phase_p2(p);
  else if constexpr (PH == 3) phase_attn0(p);
  else if constexpr (PH == 4) phase_gemm_simple<G_OUT0>(p, 4);
  else if constexpr (PH == 5) phase_gemm_simple<G_Z1>(p, 13);
  else if constexpr (PH == 6) phase_knorm(p);
  else if constexpr (PH == 7) phase_attn1(p);
  else phase_gemm_simple<G_OUT1>(p, 4);
}
#if MK_COOP
__global__ __launch_bounds__(512) void mega_coop(Params p) {
  cg::grid_group grid = cg::this_grid();
  phase_prep(p); grid.sync();
  phase_gemm1(p); grid.sync();
  phase_p2(p); grid.sync();
  phase_attn0(p); grid.sync();
  phase_gemm_simple<G_OUT0>(p, 4); grid.sync();
  phase_gemm_simple<G_Z1>(p, 13); grid.sync();
  phase_knorm(p); grid.sync();
  phase_attn1(p); grid.sync();
  phase_gemm_simple<G_OUT1>(p, 4);
}
#endif
template <int PH> __global__ __launch_bounds__(512) void mega_phase(Params p) { run_phase<PH>(p); }

extern "C" void kernel_launch(void* const* d_in, const int* in_sizes, int n_in, void* d_out, int out_size, void* d_ws, size_t ws_size, hipStream_t stream) {
  static int grid = 0;
  if (grid == 0) {
    if (n_in != 21 || out_size != NTOK * 1024 || ws_size < WS_NEED) { fprintf(stderr, "kernel_launch: unexpected shapes n_in %d out %d ws %zu\n", n_in, out_size, ws_size); grid = -1; return; }
    int dev = 0, cus = 0, per_cu = 0;
    (void)hipGetDevice(&dev); (void)hipDeviceGetAttribute(&cus, hipDeviceAttributeMultiprocessorCount, dev);
#if MK_COOP
    (void)hipFuncSetAttribute((const void*)mega_coop, hipFuncAttributeMaxDynamicSharedMemorySize, LDS_BYTES);
    (void)hipOccupancyMaxActiveBlocksPerMultiprocessor(&per_cu, (const void*)mega_coop, 512, LDS_BYTES);
#else
#define SETATTR(PH) (void)hipFuncSetAttribute((const void*)mega_phase<PH>, hipFuncAttributeMaxDynamicSharedMemorySize, LDS_BYTES)
    SETATTR(0); SETATTR(1); SETATTR(2); SETATTR(3); SETATTR(4); SETATTR(5); SETATTR(6); SETATTR(7); SETATTR(8);
    per_cu = 1;
#endif
    if (per_cu < 1) { fprintf(stderr, "kernel_launch: occupancy query says %d blocks/CU\n", per_cu); per_cu = 1; }
    grid = cus * 1;
  }
  if (grid < 0) return;
  { static const int exp_sz[21] = {8*4096*1024, 4*4096*1024, 8*256*1024, 4*256*1024, 2*1024, 2*1536*1024, 2*1024, 2*1024*1024, 2*128, 2*128,
      1024*2752, 384, 384*1536, 256, 256*2048, 192, 192, 1024*3328, 64, 64, 16};
    for (int i = 0; i < 21; ++i) if (in_sizes[i] != exp_sz[i]) { fprintf(stderr, "in_sizes[%d] = %d != %d\n", i, in_sizes[i], exp_sz[i]);
      return; } }
  Params p{};
  const float** pp = (const float**)&p;
  for (int i = 0; i < 21; ++i) pp[i] = (const float*)d_in[i];
  p.out = (float*)d_out; p.ws = (char*)d_ws;
#if MK_COOP
  void* args[] = {&p};
  hipError_t e = hipLaunchCooperativeKernel((const void*)mega_coop, dim3(grid), dim3(512), args, LDS_BYTES, stream);
  if (e != hipSuccess) fprintf(stderr, "cooperative launch failed: %s (grid %d)\n", hipGetErrorString(e), grid);
#else
#define LAUNCH(PH) hipLaunchKernelGGL(mega_phase<PH>, dim3(grid), dim3(512), LDS_BYTES, stream, p)
  LAUNCH(0); LAUNCH(1); LAUNCH(2); LAUNCH(3); LAUNCH(4); LAUNCH(5); LAUNCH(6); LAUNCH(7); LAUNCH(8);
#endif
}
```

```cpp
#include <hip/hip_runtime.h>
#include <hip/hip_bf16.h>
#include <hip/hip_cooperative_groups.h>
#include <cstdio>
#include <cstdint>
namespace cg = cooperative_groups;

#ifndef MK_COOP
#define MK_COOP 1
#endif

using bf16   = __hip_bfloat16;
using bf16x8 = __attribute__((ext_vector_type(8))) short;
using s16x4  = __attribute__((ext_vector_type(4))) short;
using f32x16 = __attribute__((ext_vector_type(16))) float;
using f32x4  = __attribute__((ext_vector_type(4))) float;
using u32x4  = __attribute__((ext_vector_type(4))) unsigned;
using u32x2  = __attribute__((ext_vector_type(2))) unsigned;
using bf2_t  = __attribute__((ext_vector_type(2))) __bf16;
#define DEVI __device__ __forceinline__
typedef const __attribute__((address_space(4))) float* cfloat_p;
#define SBAR() __builtin_amdgcn_sched_barrier(0)
#define LAUNDER_TID(tid) int tid = threadIdx.x; asm volatile("" : "+v"(tid))
#define LAUNDER_PTR(ptr) asm volatile("" : "+s"(ptr))

constexpr int NTOK = 49152, SEQ = 4096, NPROMPT_TOK = 32768;
constexpr int NMEMROW = 3072, NPROMPT_MEM = 2048;
constexpr float EPS = 1e-6f;
constexpr float LOG2E = 1.4426950408889634f;

constexpr size_t MiB = 1ull << 20;
constexpr size_t WA_BYTES = 2816ull * 1024 * 2, WB_BYTES = 3328ull * 1024 * 2, WO_BYTES = 1024ull * 1536 * 2, WM_BYTES = 1024ull * 1024 * 2;
constexpr size_t WQ_BYTES = 1536ull * 384 * 2, WKV_BYTES = 2048ull * 256 * 2, MEMKV_BYTES = 3072ull * 1024 * 2;
constexpr size_t OFF_WA = 0;
constexpr size_t OFF_WB = OFF_WA + WA_BYTES;
constexpr size_t OFF_WO = OFF_WB + WB_BYTES;
constexpr size_t OFF_WM = OFF_WO + 2 * WO_BYTES;
constexpr size_t OFF_WQ = OFF_WM + 2 * WM_BYTES;
constexpr size_t OFF_WKV = OFF_WQ + WQ_BYTES;
constexpr size_t OFF_MEMKV = OFF_WKV + WKV_BYTES;
constexpr size_t OFF_MEMB = OFF_MEMKV + 2 * MEMKV_BYTES;
constexpr size_t OFF_SS0 = OFF_MEMB + 3072ull * 1024 * 2;
constexpr size_t OFF_SS1 = OFF_SS0 + NTOK * 4ull;
constexpr size_t OFF_SSM = OFF_SS1 + NTOK * 4ull;
constexpr size_t OFF_ROPE = OFF_SSM + NMEMROW * 4ull;
constexpr size_t OFF_W_END = OFF_ROPE + 2ull * 4096 * 32 * 4;
constexpr size_t OFF_BAR = 60 * MiB - 4096;
static_assert(OFF_W_END <= OFF_BAR, "weight region overflow");
constexpr size_t OFF_XB = 60 * MiB, OFF_Q0 = 60 * MiB, OFF_K0 = 204 * MiB, OFF_V0 = 348 * MiB, OFF_ZA = 446 * MiB, OFF_MEMO0 = 446 * MiB;
constexpr size_t OFF_X1B = 204 * MiB, OFF_Z1A = 60 * MiB, OFF_KN = 180 * MiB, OFF_MEMO1 = 204 * MiB, OFF_Z1B = 300 * MiB;
constexpr size_t WS_NEED = 512 * MiB;

struct Params {
  const float *x_prompt, *x_sample, *mem_prompt, *mem_sample, *norm_in, *w_out, *mem_norm, *w_mem_kv, *mem_q_norm, *mem_k_norm;
  const float *a_w_in, *a_q_a_norm, *a_w_q_b, *a_kv_a_norm, *a_w_kv_b, *a_q_norm, *a_k_norm, *b_w_in, *b_q_norm, *b_k_norm, *b_sink;
  float* out; char* ws;
};

extern __shared__ __attribute__((aligned(16))) char g_smem[];
constexpr int LDS_BYTES = 131072;

DEVI int crow(int r, int hi) { return (r & 3) + 8 * (r >> 2) + 4 * hi; }
DEVI unsigned cvtpk(float lo, float hi) { unsigned r; asm volatile("v_cvt_pk_bf16_f32 %0, %1, %2" : "=v"(r) : "v"(lo), "v"(hi)); return r; }
DEVI float bflo(unsigned w) { return __uint_as_float(w << 16); }
DEVI float bfhi(unsigned w) { return __uint_as_float(w & 0xffff0000u); }
DEVI float swap_sum(float v) { auto rr = __builtin_amdgcn_permlane32_swap(__float_as_uint(v), __float_as_uint(v), false, false); return __uint_as_float(rr[0]) + __uint_as_float(rr[1]); }
DEVI float swap_max(float v) { auto rr = __builtin_amdgcn_permlane32_swap(__float_as_uint(v), __float_as_uint(v), false, false); return fmaxf(__uint_as_float(rr[0]), __uint_as_float(rr[1])); }
#define PK4(P, BASE, OUT) do { unsigned a0_ = cvtpk(P[BASE + 0], P[BASE + 1]), a1_ = cvtpk(P[BASE + 2], P[BASE + 3]);   \
    unsigned b0_ = cvtpk(P[BASE + 4], P[BASE + 5]), b1_ = cvtpk(P[BASE + 6], P[BASE + 7]);                              \
    auto r0_ = __builtin_amdgcn_permlane32_swap(a0_, b0_, false, false); auto r1_ = __builtin_amdgcn_permlane32_swap(a1_, b1_, false, false); \
    u32x4 w_ = {r0_[0], r1_[0], r0_[1], r1_[1]}; OUT = __builtin_bit_cast(bf16x8, w_); } while (0)
DEVI const float* x_row(const Params& p, int tok) { return tok < NPROMPT_TOK ? p.x_prompt + (size_t)tok * 1024 : p.x_sample + (size_t)(tok - NPROMPT_TOK) * 1024; }
DEVI const float* mem_row(const Params& p, int r) { return r < NPROMPT_MEM ? p.mem_prompt + (size_t)r * 1024 : p.mem_sample + (size_t)(r - NPROMPT_MEM) * 1024; }
DEVI int remap_tile(int it) {
  const int G = gridDim.x, b = blockIdx.x;
  return (G & 7) ? it * G + b : it * G + (b & 7) * (G >> 3) + (b >> 3);
}

DEVI void wt_job(const float* __restrict__ W, const float* __restrict__ g, bf16* __restrict__ out, int K, int N, int Npad, long gt, long gsz) {
  const int nq = Npad >> 2; const long total = (long)nq * (K >> 3);
  for (long i = gt; i < total; i += gsz) {
    const int n4 = (int)(i % nq) << 2; const int k0 = (int)(i / nq) << 3;
    f32x4 v[8];
    if (n4 < N) {
#pragma unroll
      for (int j = 0; j < 8; ++j) { v[j] = *reinterpret_cast<const f32x4*>(W + (size_t)(k0 + j) * N + n4); const float gj = g ? g[k0 + j] : 1.f; v[j][0] *= gj; v[j][1] *= gj; v[j][2] *= gj; v[j][3] *= gj; }
    } else {
#pragma unroll
      for (int j = 0; j < 8; ++j) v[j] = f32x4{0.f, 0.f, 0.f, 0.f};
    }
#pragma unroll
    for (int c = 0; c < 4; ++c)
      *reinterpret_cast<u32x4*>(out + (size_t)(n4 + c) * K + k0) = u32x4{cvtpk(v[0][c], v[1][c]), cvtpk(v[2][c], v[3][c]), cvtpk(v[4][c], v[5][c]), cvtpk(v[6][c], v[7][c])};
  }
}
DEVI void row_job4(const Params& p, int r0, int lane) {
  char* ws = p.ws;
  f32x4 v[4][4];
#pragma unroll
  for (int k = 0; k < 4; ++k) { const int r = r0 + k;
    const float* src = r < NTOK ? x_row(p, r) : mem_row(p, r - NTOK);
#pragma unroll
    for (int i = 0; i < 2; ++i) { v[k][2 * i] = *reinterpret_cast<const f32x4*>(src + lane * 8 + 512 * i); v[k][2 * i + 1] = *reinterpret_cast<const f32x4*>(src + lane * 8 + 512 * i + 4); } }
#pragma unroll
  for (int k = 0; k < 4; ++k) { const int r = r0 + k;
    bf16* dst = r < NTOK ? (bf16*)(ws + OFF_XB) + (size_t)r * 1024 : (bf16*)(ws + OFF_MEMB) + (size_t)(r - NTOK) * 1024;
    float ss = 0.f;
#pragma unroll
    for (int i = 0; i < 2; ++i) { const f32x4 a = v[k][2 * i], c = v[k][2 * i + 1];
      ss += a[0] * a[0] + a[1] * a[1] + a[2] * a[2] + a[3] * a[3] + c[0] * c[0] + c[1] * c[1] + c[2] * c[2] + c[3] * c[3];
      *reinterpret_cast<u32x4*>(dst + lane * 8 + 512 * i) = u32x4{cvtpk(a[0], a[1]), cvtpk(a[2], a[3]), cvtpk(c[0], c[1]), cvtpk(c[2], c[3])}; }
#pragma unroll
    for (int o = 32; o > 0; o >>= 1) ss += __shfl_xor(ss, o, 64);
    if (lane == 0) { if (r < NTOK) ((float*)(ws + OFF_SS0))[r] = ss; else ((float*)(ws + OFF_SSM))[r - NTOK] = ss; }
  }
}
DEVI void phase_prep(const Params& p) {
  char* ws = p.ws; LAUNDER_TID(tid);
  const long gt = (long)blockIdx.x * 512 + tid, gsz = (long)gridDim.x * 512;
  wt_job(p.a_w_in, p.norm_in, (bf16*)(ws + OFF_WA), 1024, 2752, 2816, gt, gsz);
  wt_job(p.b_w_in, p.norm_in + 1024, (bf16*)(ws + OFF_WB), 1024, 3328, 3328, gt, gsz);
  wt_job(p.w_out, nullptr, (bf16*)(ws + OFF_WO), 1536, 1024, 1024, gt, gsz);
  wt_job(p.w_out + 1536 * 1024, nullptr, (bf16*)(ws + OFF_WO + WO_BYTES), 1536, 1024, 1024, gt, gsz);
  wt_job(p.w_mem_kv, p.mem_norm, (bf16*)(ws + OFF_WM), 1024, 1024, 1024, gt, gsz);
  wt_job(p.w_mem_kv + 1024 * 1024, p.mem_norm + 1024, (bf16*)(ws + OFF_WM + WM_BYTES), 1024, 1024, 1024, gt, gsz);
  wt_job(p.a_w_q_b, p.a_q_a_norm, (bf16*)(ws + OFF_WQ), 384, 1536, 1536, gt, gsz);
  wt_job(p.a_w_kv_b, p.a_kv_a_norm, (bf16*)(ws + OFF_WKV), 256, 2048, 2048, gt, gsz);
  float* rc = (float*)(ws + OFF_ROPE); float* rs = rc + 4096 * 32;
  for (long i = gt; i < 4096 * 32; i += gsz) {
    const int pos = (int)(i >> 5), f = (int)(i & 31);
    const float inv = exp2f(-(float)f * (13.287712379549449f / 32.f));
    float rev = (float)pos * inv * 0.15915494309189535f; rev -= floorf(rev);
    rc[i] = __builtin_amdgcn_cosf(rev); rs[i] = __builtin_amdgcn_sinf(rev);
  }
  float* ss1 = (float*)(ws + OFF_SS1);
  for (long i = gt; i < NTOK; i += gsz) ss1[i] = 0.f;
  const int wid = tid >> 6, lane = tid & 63;
  const int nw = gridDim.x * 8;
  for (int r = (blockIdx.x * 8 + wid) * 4; r < NTOK + NMEMROW; r += nw * 4) row_job4(p, r, lane);
}

enum { G_Z0 = 0, G_MKV0 = 1, G_MKV1 = 2, G_OUT0 = 3, G_Z1 = 4, G_OUT1 = 5 };
constexpr int BK = 64, HALF = 128, HT = HALF * BK;
DEVI int lds_byte(int r, int c) { int st = (r >> 4) * 2 + (c >> 5), rr = r & 15, cc = c & 31, ob = rr * 64 + cc * 2; return st * 1024 + (ob ^ (((ob >> 9) & 1) << 5)); }
DEVI void stage_rc(int b, int& R, int& C) { int st = b / 1024, sb = b % 1024, swz = sb ^ (((sb >> 9) & 1) << 5); R = (st >> 1) * 16 + swz / 64; C = (st & 1) * 32 + (swz % 64) / 2; }

template <int MODE> DEVI const bf16* a_ptr(const Params& p, int kt, int& lda) {
  char* ws = p.ws; const int k = kt * 64;
  if constexpr (MODE == G_Z0) { lda = 1024; return (const bf16*)(ws + OFF_XB) + k; }
  else if constexpr (MODE == G_MKV0 || MODE == G_MKV1) { lda = 1024; return (const bf16*)(ws + OFF_MEMB) + k; }
  else if constexpr (MODE == G_Z1) { lda = 1024; return (const bf16*)(ws + OFF_X1B) + k; }
  else if constexpr (MODE == G_OUT0) {
    if (k < 1024) { lda = 1536; return (const bf16*)(ws + OFF_Q0) + (k >> 7) * 192 + (k & 127); }
    lda = 512; return (const bf16*)(ws + OFF_MEMO0) + (k - 1024);
  } else {
    if (k < 1024) { lda = 1280; return (const bf16*)(ws + OFF_Z1A) + k; }
    lda = 512; return (const bf16*)(ws + OFF_MEMO1) + (k - 1024);
  }
}

template <int MODE>
DEVI void gemm_tile(const Params& p, int pm, int pn) {
  constexpr int K = (MODE == G_OUT0 || MODE == G_OUT1) ? 1536 : 1024;
  constexpr int nt = K / BK;
  char* ws = p.ws; LAUNDER_TID(tid);
  const bf16* Bt = (const bf16*)(ws + (MODE == G_Z0 ? OFF_WA : MODE == G_MKV0 ? OFF_WM : MODE == G_MKV1 ? OFF_WM + WM_BYTES : MODE == G_OUT0 ? OFF_WO : MODE == G_Z1 ? OFF_WB : OFF_WO + WO_BYTES));
  bf16* shm = (bf16*)g_smem;
  const int brow = pm * 256, bcol = pn * 256;
#define SA(b, h) (shm + ((b) * 2 + (h)) * HT)
#define SB(b, h) (shm + (4 + (b) * 2 + (h)) * HT)
#define STAGE_B(P, half, kt) do { const bf16* _g = Bt + (size_t)(bcol + (half) * HALF) * K + (size_t)(kt) * BK;              \
    _Pragma("unroll") for (int _i = 0; _i < 2; ++_i)                                                                          \
      __builtin_amdgcn_global_load_lds((const unsigned*)(_g + ((st_rc[_i] & 255) * K + (st_rc[_i] >> 8))), (unsigned*)((char*)(P) + tid * 16 + _i * 8192), 16, 0, 0); } while (0)
#define STAGE_A(P, half, kt) do { int _lda; const bf16* _g = a_ptr<MODE>(p, (kt), _lda) + (size_t)(brow + (half) * HALF) * _lda; \
    _Pragma("unroll") for (int _i = 0; _i < 2; ++_i)                                                                          \
      __builtin_amdgcn_global_load_lds((const unsigned*)(_g + ((st_rc[_i] & 255) * _lda + (st_rc[_i] >> 8))), (unsigned*)((char*)(P) + tid * 16 + _i * 8192), 16, 0, 0); } while (0)
#define LDA(dst, b, h) for (int m = 0; m < 4; ++m) for (int k = 0; k < 2; ++k) \
    dst[m][k] = *reinterpret_cast<const bf16x8*>((char*)SA(b, h) + lds_byte(wr * 64 + m * 16 + fr, k * 32 + fq * 8))
#define LDB(dst, b, h) for (int n = 0; n < 2; ++n) for (int k = 0; k < 2; ++k) \
    dst[n][k] = *reinterpret_cast<const bf16x8*>((char*)SB(b, h) + lds_byte(wc * 32 + n * 16 + fr, k * 32 + fq * 8))
#define MMA(ai, bj, At_, Bt_) do { __builtin_amdgcn_s_setprio(1); \
    for (int m = 0; m < 4; ++m) for (int n = 0; n < 2; ++n) for (int k = 0; k < 2; ++k) \
      acc[ai][bj][m][n] = __builtin_amdgcn_mfma_f32_16x16x32_bf16(Bt_[n][k], At_[m][k], acc[ai][bj][m][n], 0, 0, 0); \
    __builtin_amdgcn_s_setprio(0); } while (0)
#define WAIT_V(n) asm volatile("s_waitcnt vmcnt(" #n ")" ::: "memory")
#define WAIT_L(n) asm volatile("s_waitcnt lgkmcnt(" #n ")" ::: "memory")
#define BAR __builtin_amdgcn_s_barrier()
  const int wid = tid >> 6, lane = tid & 63, wr = wid >> 2, wc = wid & 3, fr = lane & 15, fq = lane >> 4;
  f32x4 acc[2][2][4][2] = {};
  bf16x8 At[4][2], B0[2][2], B1[2][2];
  int st_rc[2];
#pragma unroll
  for (int i = 0; i < 2; ++i) { int r_, c_; stage_rc(tid * 16 + i * 8192, r_, c_); st_rc[i] = r_ | (c_ << 8); }
  __syncthreads();
  STAGE_B(SB(0, 0), 0, 0); STAGE_A(SA(0, 0), 0, 0);
  STAGE_B(SB(0, 1), 1, 0); STAGE_A(SA(0, 1), 1, 0);
  if (wr == 1) BAR;
  WAIT_V(4); BAR;
  STAGE_B(SB(1, 0), 0, 1); STAGE_A(SA(1, 0), 0, 1); STAGE_B(SB(1, 1), 1, 1);
  WAIT_V(6); BAR;
  for (int t = 0; t < nt - 2; t += 2) {
    LDB(B0, 0, 0); SBAR(); LDA(At, 0, 0); STAGE_A(SA(1, 1), 1, t + 1);
    WAIT_L(8); BAR; WAIT_L(0); MMA(0, 0, At, B0); BAR; SBAR();
    LDB(B1, 0, 1); STAGE_B(SB(0, 0), 0, t + 2);
    BAR; WAIT_L(0); MMA(0, 1, At, B1); BAR;
    LDA(At, 0, 1); STAGE_A(SA(0, 0), 0, t + 2);
    BAR; WAIT_L(0); MMA(1, 0, At, B0); BAR; SBAR();
    STAGE_B(SB(0, 1), 1, t + 2);
    WAIT_V(6); BAR; MMA(1, 1, At, B1); BAR;
    LDB(B0, 1, 0); SBAR(); LDA(At, 1, 0); STAGE_A(SA(0, 1), 1, t + 2);
    WAIT_L(8); BAR; WAIT_L(0); MMA(0, 0, At, B0); BAR; SBAR();
    LDB(B1, 1, 1); STAGE_B(SB(1, 0), 0, t + 3);
    BAR; WAIT_L(0); MMA(0, 1, At, B1); BAR;
    LDA(At, 1, 1); STAGE_A(SA(1, 0), 0, t + 3);
    BAR; WAIT_L(0); MMA(1, 0, At, B0); BAR; SBAR();
    STAGE_B(SB(1, 1), 1, t + 3);
    WAIT_V(6); BAR; MMA(1, 1, At, B1); BAR;
  }
  { LDB(B0, 0, 0); LDA(At, 0, 0); STAGE_A(SA(1, 1), 1, nt - 1);
    BAR; WAIT_L(0); MMA(0, 0, At, B0); BAR;
    LDB(B1, 0, 1); BAR; WAIT_L(0); MMA(0, 1, At, B1); BAR;
    LDA(At, 0, 1); WAIT_V(4); BAR; WAIT_L(0); MMA(1, 0, At, B0); MMA(1, 1, At, B1); BAR; }
  { LDB(B0, 1, 0); LDA(At, 1, 0); WAIT_V(2); BAR; WAIT_L(0); MMA(0, 0, At, B0); BAR;
    LDB(B1, 1, 1); WAIT_V(0); BAR; WAIT_L(0); MMA(0, 1, At, B1); BAR;
    LDA(At, 1, 1); BAR; WAIT_L(0); MMA(1, 0, At, B0); MMA(1, 1, At, B1); BAR; }
  if (wr == 0) BAR;
#undef SA
#undef SB
#undef STAGE_A
#undef STAGE_B
#undef LDA
#undef LDB
#undef MMA
  float rs8[2][4];
  if constexpr (MODE == G_Z0 || MODE == G_Z1 || MODE == G_MKV0 || MODE == G_MKV1) {
    const float* ssp = (const float*)(ws + (MODE == G_Z0 ? OFF_SS0 : MODE == G_Z1 ? OFF_SS1 : OFF_SSM));
#pragma unroll
    for (int ai = 0; ai < 2; ++ai)
#pragma unroll
      for (int m = 0; m < 4; ++m) rs8[ai][m] = ssp[brow + ai * HALF + wr * 64 + m * 16 + fr];
#pragma unroll
    for (int ai = 0; ai < 2; ++ai)
#pragma unroll
      for (int m = 0; m < 4; ++m) rs8[ai][m] = rsqrtf(rs8[ai][m] * (1.f / 1024.f) + EPS);
  }
#pragma unroll
  for (int ai = 0; ai < 2; ++ai) {
    f32x4 resv[4][4];
    if constexpr (MODE == G_OUT0 || MODE == G_OUT1) {
#pragma unroll
      for (int m = 0; m < 4; ++m) { const int row = brow + ai * HALF + wr * 64 + m * 16 + fr;
        const float* res = (MODE == G_OUT0) ? x_row(p, row) : p.out + (size_t)row * 1024;
#pragma unroll
        for (int bj = 0; bj < 2; ++bj)
#pragma unroll
          for (int n = 0; n < 2; ++n) resv[m][bj * 2 + n] = *reinterpret_cast<const f32x4*>(res + bcol + bj * HALF + wc * 32 + n * 16 + fq * 4); }
    }
#pragma unroll
    for (int m = 0; m < 4; ++m) {
      const int row = brow + ai * HALF + wr * 64 + m * 16 + fr;
      if constexpr (MODE == G_Z0 || MODE == G_Z1 || MODE == G_MKV0 || MODE == G_MKV1) {
        const float rs = rs8[ai][m];
#pragma unroll
        for (int bj = 0; bj < 2; ++bj) {
          const f32x4 a0 = acc[ai][bj][m][0], a1 = acc[ai][bj][m][1];
          const unsigned x0 = cvtpk(a0[0] * rs, a0[1] * rs), x1 = cvtpk(a0[2] * rs, a0[3] * rs);
          const unsigned y0 = cvtpk(a1[0] * rs, a1[1] * rs), y1 = cvtpk(a1[2] * rs, a1[3] * rs);
          const auto s0 = __builtin_amdgcn_permlane16_swap(x0, y0, false, false), s1 = __builtin_amdgcn_permlane16_swap(x1, y1, false, false);
          const u32x4 w = {s0[0], s1[0], s0[1], s1[1]};
          const int col = bcol + bj * HALF + wc * 32 + (fq & 1) * 16 + (fq >> 1) * 8;
          if constexpr (MODE == G_Z0) {
            if (col < 704) *reinterpret_cast<u32x4*>((bf16*)(ws + OFF_ZA) + (size_t)row * 704 + col) = w;
            else if (col < 2752) *reinterpret_cast<u32x4*>((bf16*)p.out + (size_t)row * 2048 + (col - 704)) = w;
          } else if constexpr (MODE == G_Z1) {
            if (col < 1280) *reinterpret_cast<u32x4*>((bf16*)(ws + OFF_Z1A) + (size_t)row * 1280 + col) = w;
            else *reinterpret_cast<u32x4*>((bf16*)(ws + OFF_Z1B) + (size_t)row * 2048 + (col - 1280)) = w;
          } else {
            *reinterpret_cast<u32x4*>((bf16*)(ws + OFF_MEMKV + (MODE == G_MKV1 ? MEMKV_BYTES : 0)) + (size_t)row * 1024 + col) = w;
          }
        }
      } else {
        float* dst = p.out + (size_t)row * 1024;
        float ssl = 0.f;
#pragma unroll
        for (int bj = 0; bj < 2; ++bj)
#pragma unroll
          for (int n = 0; n < 2; ++n) {
            const int col = bcol + bj * HALF + wc * 32 + n * 16 + fq * 4;
            const f32x4 a = acc[ai][bj][m][n];
            f32x4 x = resv[m][bj * 2 + n];
            x[0] += a[0]; x[1] += a[1]; x[2] += a[2]; x[3] += a[3];
            *reinterpret_cast<f32x4*>(dst + col) = x;
            if constexpr (MODE == G_OUT0) {
              ssl += x[0] * x[0] + x[1] * x[1] + x[2] * x[2] + x[3] * x[3];
              *reinterpret_cast<u32x2*>((bf16*)(ws + OFF_X1B) + (size_t)row * 1024 + col) = u32x2{cvtpk(x[0], x[1]), cvtpk(x[2], x[3])};
            }
          }
        if constexpr (MODE == G_OUT0) {
          ssl += __shfl_xor(ssl, 16, 64); ssl += __shfl_xor(ssl, 32, 64);
          if (fq == 0) atomicAdd((float*)(ws + OFF_SS1) + row, ssl);
        }
      }
    }
  }
}

template <int MODE> DEVI void gemm_tiles_grouped(const Params& p, int t, int nM, int nN) {
  constexpr int WGM = 8;
  const int nig = WGM * nN, gid = t / nig, fm = gid * WGM, gsz = min(nM - fm, WGM);
  const int pm = fm + ((t % nig) % gsz), pn = (t % nig) / gsz;
  gemm_tile<MODE>(p, pm, pn);
}

DEVI void phase_gemm1(const Params& p) {
  constexpr int NZ = 192 * 11, NT = NZ + 2 * 48;
  for (int it = 0;; ++it) {
    const int t = remap_tile(it); if (it * (int)gridDim.x >= NT) break; if (t >= NT) continue;
    if (t < NZ) gemm_tiles_grouped<G_Z0>(p, t, 192, 11);
    else { const int u = t - NZ; if (u < 48) gemm_tile<G_MKV0>(p, u % 12, u / 12); else gemm_tile<G_MKV1>(p, (u - 48) % 12, (u - 48) / 12); }
  }
}
template <int MODE> DEVI void phase_gemm_simple(const Params& p, int nN) {
  const int NT = 192 * nN;
  for (int it = 0;; ++it) {
    const int t = remap_tile(it); if (it * (int)gridDim.x >= NT) break; if (t >= NT) continue;
    gemm_tiles_grouped<MODE>(p, t, 192, nN);
  }
}

DEVI int swz128(int row, int ch) { return row * 128 + ((ch ^ ((row >> 1) & 7)) << 4); }

template <int KDIM, int NB>
DEVI void small_gemm(const bf16* __restrict__ A  , int lda, const bf16* __restrict__ W  ,
                     f32x16 (&acc)[NB], float& ssrow, int tid) {
  constexpr int NC = KDIM / 64, WPT = NB * 32 * 8 / 512;
  const int wid = tid >> 6, lane = tid & 63, r32 = lane & 31, hi = lane >> 5;
  char* lds = g_smem;
  int aoff[4], woff[WPT];
#pragma unroll
  for (int i_ = 0; i_ < 4; ++i_) { const int q_ = tid + 512 * i_, row_ = q_ >> 3, ch_ = (q_ & 7) ^ ((row_ >> 1) & 7); aoff[i_] = row_ * lda + ch_ * 8; }
#pragma unroll
  for (int i_ = 0; i_ < WPT; ++i_) { const int q_ = tid + 512 * i_, row_ = q_ >> 3, ch_ = (q_ & 7) ^ ((row_ >> 1) & 7); woff[i_] = row_ * KDIM + ch_ * 8; }
#define SG_LOAD(b, c) do { const bf16* ag_ = A + (c) * 64; const bf16* wg_ = W + (c) * 64;                                     \
    _Pragma("unroll") for (int i_ = 0; i_ < 4; ++i_)                                                                           \
      __builtin_amdgcn_global_load_lds((const unsigned*)(ag_ + aoff[i_]), (unsigned*)(lds + (b) * 32768 + (tid + 512 * i_) * 16), 16, 0, 0); \
    _Pragma("unroll") for (int i_ = 0; i_ < WPT; ++i_)                                                                         \
      __builtin_amdgcn_global_load_lds((const unsigned*)(wg_ + woff[i_]), (unsigned*)(lds + 65536 + (b) * 32768 + (tid + 512 * i_) * 16), 16, 0, 0); } while (0)
#pragma unroll
  for (int nb = 0; nb < NB; ++nb) acc[nb] = f32x16{};
  float ss = 0.f;
  __syncthreads();
  SG_LOAD(0, 0); asm volatile("s_waitcnt vmcnt(0)" ::: "memory"); __syncthreads();
#pragma unroll 1
  for (int c = 0; c < NC; ++c) {
    const int b = c & 1;
    if (c + 1 < NC) SG_LOAD(b ^ 1, c + 1);
#pragma unroll
    for (int ks = 0; ks < 4; ++ks) {
      const int ch = ks * 2 + hi;
      const bf16x8 a = *reinterpret_cast<const bf16x8*>(lds + b * 32768 + swz128(wid * 32 + r32, ch));
      const u32x4 au = __builtin_bit_cast(u32x4, a);
#pragma unroll
      for (int j = 0; j < 4; ++j) { const float lo = bflo(au[j]), h2 = bfhi(au[j]); ss += lo * lo + h2 * h2; }
#pragma unroll
      for (int nb = 0; nb < NB; ++nb) {
        const bf16x8 w = *reinterpret_cast<const bf16x8*>(lds + 65536 + b * 32768 + swz128(nb * 32 + r32, ch));
        acc[nb] = __builtin_amdgcn_mfma_f32_32x32x16_bf16(w, a, acc[nb], 0, 0, 0);
      }
      SBAR();
    }
    asm volatile("s_waitcnt vmcnt(0)" ::: "memory"); __syncthreads();
  }
  ssrow = swap_sum(ss);
#undef SG_LOAD
}

DEVI void rope_pair(f32x16& x1, f32x16& x2, const float* __restrict__ rc, const float* __restrict__ rs, int pos, int hi) {
#pragma unroll
  for (int g = 0; g < 4; ++g) {
    const f32x4 c = *reinterpret_cast<const f32x4*>(rc + pos * 32 + 8 * g + 4 * hi);
    const f32x4 s = *reinterpret_cast<const f32x4*>(rs + pos * 32 + 8 * g + 4 * hi);
#pragma unroll
    for (int j = 0; j < 4; ++j) { const float a = x1[4 * g + j], b = x2[4 * g + j]; x1[4 * g + j] = a * c[j] - b * s[j]; x2[4 * g + j] = b * c[j] + a * s[j]; }
  }
}
DEVI void store_blk(bf16* __restrict__ dst  , const f32x16& v, int hi) {
  bf16x8 o0, o1; PK4(v, 0, o0); PK4(v, 8, o1);
  *reinterpret_cast<bf16x8*>(dst + hi * 8) = o0; *reinterpret_cast<bf16x8*>(dst + 16 + hi * 8) = o1;
}

DEVI void scale_gain_blk(f32x16& v, const f32x16& a, float f, const float* __restrict__ gain  , int hi) {
#pragma unroll
  for (int g = 0; g < 4; ++g) {
    const f32x4 gn = *reinterpret_cast<const f32x4*>(gain + 8 * g + 4 * hi);
#pragma unroll
    for (int j = 0; j < 4; ++j) v[4 * g + j] = a[4 * g + j] * (f * gn[j]);
  }
}
DEVI void gain_inplace(f32x16& v, float f, const float* __restrict__ gain, int hi) {
  float gs[32];
  cfloat_p cg = (cfloat_p)(uintptr_t)gain;
#pragma unroll
  for (int i = 0; i < 32; ++i) gs[i] = cg[i];
#pragma unroll
  for (int g = 0; g < 4; ++g)
#pragma unroll
    for (int j = 0; j < 4; ++j) v[4 * g + j] *= f * (hi ? gs[8 * g + 4 + j] : gs[8 * g + j]);
}
DEVI void rope_cs(int pos, int i, float& c, float& s) {
  const float inv = __builtin_amdgcn_exp2f(-(float)i * (13.287712379549449f / 32.f)) * 0.15915494309189535f;
  float rev = (float)pos * inv; rev -= floorf(rev);
  c = __builtin_amdgcn_cosf(rev); s = __builtin_amdgcn_sinf(rev);
}
DEVI void rope_inplace(f32x16& x1, f32x16& x2, int pos, int hi) {
#pragma unroll
  for (int g = 0; g < 4; ++g)
#pragma unroll
    for (int j = 0; j < 4; ++j) { float c, s; rope_cs(pos, 8 * g + 4 * hi + j, c, s);
      const float a = x1[4 * g + j], b = x2[4 * g + j]; x1[4 * g + j] = a * c - b * s; x2[4 * g + j] = b * c + a * s; }
}
DEVI void p2_epi_q(const Params& p, f32x16 (&acc)[6], float rs, int tok, int h, int hi) {
  char* ws = p.ws; LAUNDER_PTR(ws);
  float hs = 0.f;
#pragma unroll
  for (int nb = 0; nb < 6; ++nb)
#pragma unroll
    for (int r = 0; r < 16; ++r) hs += acc[nb][r] * acc[nb][r];
  hs = swap_sum(hs) * rs * rs;
  const float f = rs * rsqrtf(hs * (1.f / 192.f) + EPS) * (0.07216878364870322f * LOG2E);
  const int pos = tok & (SEQ - 1);
  bf16* dst = (bf16*)(ws + OFF_Q0) + (size_t)tok * 1536 + h * 192;
  SBAR();
  gain_inplace(acc[4], f, p.a_q_norm + 128, hi); gain_inplace(acc[5], f, p.a_q_norm + 160, hi);
  rope_inplace(acc[4], acc[5], pos, hi);
  store_blk(dst + 128, acc[4], hi); SBAR(); store_blk(dst + 160, acc[5], hi); SBAR();
#pragma unroll
  for (int nb = 0; nb < 4; ++nb) { gain_inplace(acc[nb], f, p.a_q_norm + nb * 32, hi); store_blk(dst + nb * 32, acc[nb], hi); SBAR(); }
}
DEVI void p2_epi_k(const Params& p, f32x16 (&acc)[4], float rs, int tok, int h, int hi, const u32x2 (&kra)[4], const u32x2 (&krb)[4], float kq) {
  char* ws = p.ws; LAUNDER_PTR(ws);
  const int pos = tok & (SEQ - 1);
  float ks = 0.f;
#pragma unroll
  for (int nb = 0; nb < 4; ++nb)
#pragma unroll
    for (int r = 0; r < 16; ++r) ks += acc[nb][r] * acc[nb][r];
  ks = swap_sum(ks * rs * rs + kq);
  const float rk = rsqrtf(ks * (1.f / 192.f) + EPS);
  bf16* kd = (bf16*)(ws + OFF_K0) + (size_t)tok * 1536 + h * 192;
  SBAR();
  float g1s[32], g2s[32];
  { cfloat_p ck = (cfloat_p)(uintptr_t)p.a_k_norm;
#pragma unroll
    for (int i = 0; i < 32; ++i) { g1s[i] = ck[128 + i]; g2s[i] = ck[160 + i]; } }
#pragma unroll
  for (int hf = 0; hf < 2; ++hf) {
    float x1[8], x2[8];
#pragma unroll
    for (int gg = 0; gg < 2; ++gg) {
      const int g = 2 * hf + gg;
      const u32x2 a = kra[g], b = krb[g];
      const float av[4] = {bflo(a[0]), bfhi(a[0]), bflo(a[1]), bfhi(a[1])}, bv[4] = {bflo(b[0]), bfhi(b[0]), bflo(b[1]), bfhi(b[1])};
#pragma unroll
      for (int j = 0; j < 4; ++j) { float c, sn; rope_cs(pos, 8 * g + 4 * hi + j, c, sn);
        const float u = av[j] * rk * (hi ? g1s[8 * g + 4 + j] : g1s[8 * g + j]), w = bv[j] * rk * (hi ? g2s[8 * g + 4 + j] : g2s[8 * g + j]);
        x1[4 * gg + j] = u * c - w * sn; x2[4 * gg + j] = w * c + u * sn; }
    }
    bf16x8 o1, o2; PK4(x1, 0, o1); PK4(x2, 0, o2);
    *reinterpret_cast<bf16x8*>(kd + 128 + hf * 16 + hi * 8) = o1; *reinterpret_cast<bf16x8*>(kd + 160 + hf * 16 + hi * 8) = o2;
  }
#pragma unroll
  for (int nb = 0; nb < 4; ++nb) { gain_inplace(acc[nb], rs * rk, p.a_k_norm + nb * 32, hi); store_blk(kd + nb * 32, acc[nb], hi); SBAR(); }
}
DEVI void p2_epi_v(const Params& p, f32x16 (&acc)[4], float rs, int tok, int h, int hi) {
  char* ws = p.ws; LAUNDER_PTR(ws);
  bf16* vd = (bf16*)(ws + OFF_V0) + (size_t)tok * 1024 + h * 128;
#pragma unroll
  for (int nb = 0; nb < 4; ++nb) {
#pragma unroll
    for (int r = 0; r < 16; ++r) acc[nb][r] *= rs;
    store_blk(vd + nb * 32, acc[nb], hi); SBAR();
  }
}

template <bool ISQ>
DEVI void p2_job(const Params& p, int mt, int half) {
  constexpr int KDIM = ISQ ? 384 : 256, NFR = KDIM / 16, NB = ISQ ? 6 : 4, NC = KDIM / 64, NPART = ISQ ? 4 : 8;
  constexpr int ROWS = NB * 32, LPC = ROWS * 8 / 512, STG = ROWS * 128, NSTG = ISQ ? 4 : 5, DEPTH = NSTG - 1;
  constexpr int NFH = ISQ ? NFR - 4 : NFR;
  char* ws = p.ws; LAUNDER_PTR(ws); char* lds = g_smem;
  LAUNDER_TID(tid); const int wid = tid >> 6, lane = tid & 63, r32 = lane & 31, hi = lane >> 5;
  const int tok = mt * 256 + wid * 32 + r32;
  const bf16* Wb = ISQ ? (const bf16*)(ws + OFF_WQ) + (size_t)(half * 4) * 192 * 384 : (const bf16*)(ws + OFF_WKV) + (size_t)(half * 4) * 256 * 256;
  int ip = 0, ic = 0, si = 0;
#define P2_ISSUE() do { const bf16* wg_ = Wb + (size_t)ip * (ROWS * KDIM) + ic * 64; const unsigned woff0 = (tid >> 3) * KDIM + (((tid & 7) ^ ((tid >> 4) & 7)) * 8); \
    _Pragma("unroll") for (int i_ = 0; i_ < LPC; ++i_)                                                                          \
      __builtin_amdgcn_global_load_lds((const unsigned*)((wg_ + i_ * 64 * KDIM) + woff0), (unsigned*)(lds + si * STG + (tid + 512 * i_) * 16), 16, 0, 0); \
    si = (si == NSTG - 1) ? 0 : si + 1;                                                                                         \
    if (!(ip == NPART - 1 && ic == NC - 1)) { if (++ic == NC) { ic = 0; ++ip; } } } while (0)
  const bf16* arow = (const bf16*)(ws + OFF_ZA) + (size_t)tok * 704 + (ISQ ? 0 : 384) + hi * 8;
  float ss = 0.f;
#pragma unroll
  for (int f = 0; f < NFR; ++f) { const u32x4 au = *reinterpret_cast<const u32x4*>(arow + f * 16);
#pragma unroll
    for (int j = 0; j < 4; ++j) { const float lo = bflo(au[j]), h2 = bfhi(au[j]); ss += lo * lo + h2 * h2; } }
  const float rs = rsqrtf(swap_sum(ss) * (1.f / KDIM) + EPS);
  asm volatile("" ::: "memory"); SBAR();
  __syncthreads();
  P2_ISSUE(); P2_ISSUE(); P2_ISSUE(); if constexpr (DEPTH == 4) P2_ISSUE();
  SBAR();
  bf16x8 af[NFH];
#pragma unroll
  for (int f = 0; f < NFH; ++f) af[f] = *reinterpret_cast<const bf16x8*>(arow + f * 16);
  char* apark = lds + NSTG * STG + wid * 4096 + lane * 16;
  if constexpr (ISQ) {
#pragma unroll
    for (int f = 0; f < 4; ++f) { const bf16x8 t = *reinterpret_cast<const bf16x8*>(arow + (NFH + f) * 16); *reinterpret_cast<bf16x8*>(apark + f * 1024) = t; }
  }
  asm volatile("s_waitcnt vmcnt(0)" ::: "memory");
  u32x2 kra[4] = {}, krb[4] = {}; float kq = 0.f;
  if constexpr (!ISQ) {
    const bf16* kr = (const bf16*)(ws + OFF_ZA) + (size_t)tok * 704 + 640;
#pragma unroll
    for (int g = 0; g < 4; ++g) { kra[g] = *reinterpret_cast<const u32x2*>(kr + 8 * g + 4 * hi); krb[g] = *reinterpret_cast<const u32x2*>(kr + 32 + 8 * g + 4 * hi); }
#pragma unroll
    for (int g = 0; g < 4; ++g) {
      kq += bflo(kra[g][0]) * bflo(kra[g][0]) + bfhi(kra[g][0]) * bfhi(kra[g][0]) + bflo(kra[g][1]) * bflo(kra[g][1]) + bfhi(kra[g][1]) * bfhi(kra[g][1]);
      kq += bflo(krb[g][0]) * bflo(krb[g][0]) + bfhi(krb[g][0]) * bfhi(krb[g][0]) + bflo(krb[g][1]) * bflo(krb[g][1]) + bfhi(krb[g][1]) * bfhi(krb[g][1]);
    }
  }
  int sc = 0;
#define P2_PART() do {                                                                                                           \
    _Pragma("unroll") for (int nb = 0; nb < NB; ++nb) acc[nb] = f32x16{};                                                       \
    _Pragma("unroll") for (int c = 0; c < NC; ++c) {                                                                            \
      if (c >= DEPTH) asm volatile("s_waitcnt vmcnt(%0)" :: "n"((DEPTH - 1) * LPC) : "memory");                                  \
      __builtin_amdgcn_s_barrier();                                                                                              \
      P2_ISSUE();                                                                                                                \
      const char* wl = lds + sc * STG;                                                                                           \
      _Pragma("unroll") for (int ks = 0; ks < 4; ++ks) {                                                                        \
        const int ch = ks * 2 + hi; bf16x8 afl = {};                                                                             \
        if (c * 4 + ks >= NFH) afl = *reinterpret_cast<const bf16x8*>(apark + (c * 4 + ks - NFH) * 1024);                        \
        _Pragma("unroll") for (int nb = 0; nb < NB; ++nb) {                                                                     \
          const bf16x8 w = *reinterpret_cast<const bf16x8*>(wl + swz128(nb * 32 + r32, ch));                                     \
          acc[nb] = __builtin_amdgcn_mfma_f32_32x32x16_bf16(w, (c * 4 + ks < NFH) ? af[(c * 4 + ks < NFH) ? c * 4 + ks : 0] : afl, acc[nb], 0, 0, 0); \
          if (NB == 6 && nb == 2) SBAR();                                                                                        \
        }                                                                                                                        \
        SBAR();                                                                                                                  \
      }                                                                                                                          \
      sc = (sc == NSTG - 1) ? 0 : sc + 1;                                                                                        \
    } } while (0)
#pragma unroll 1
  for (int pi = 0; pi < NPART; ++pi) {
    f32x16 acc[NB];
    P2_PART();
    asm volatile("s_waitcnt vmcnt(0)" ::: "memory");
    { LAUNDER_TID(t2); const int tok2 = mt * 256 + (t2 >> 6) * 32 + (t2 & 31), hi2 = (t2 >> 5) & 1;
      if constexpr (ISQ) p2_epi_q(p, acc, rs, tok2, half * 4 + pi, hi2);
      else { if (pi & 1) p2_epi_v(p, acc, rs, tok2, half * 4 + (pi >> 1), hi2); else p2_epi_k(p, acc, rs, tok2, half * 4 + (pi >> 1), hi2, kra, krb, kq); } }
  }
  asm volatile("s_waitcnt vmcnt(0)" ::: "memory");
#undef P2_PART
#undef P2_ISSUE
}

DEVI void phase_p2(const Params& p) {
  constexpr int NJ = 768;
  for (int it = 0;; ++it) {
    const int t = remap_tile(it); if (it * (int)gridDim.x >= NJ) break; if (t >= NJ) continue;
    const int mt = t >> 2, sub = t & 3;
    if (sub < 2) p2_job<true>(p, mt, sub); else p2_job<false>(p, mt, sub - 2);
  }
  char* ws = p.ws; LAUNDER_TID(tid);
  const int wid = tid >> 6, lane = tid & 63, nw = gridDim.x * 8;
  for (int r = blockIdx.x * 8 + wid; r < 2 * NMEMROW; r += nw) {
    const int l = r / NMEMROW, row = r % NMEMROW;
    bf16* kp = (bf16*)(ws + OFF_MEMKV + (size_t)l * MEMKV_BYTES) + (size_t)row * 1024;
    const float* gn = p.mem_k_norm + l * 128;
    {
      const int col = lane * 8;
      const u32x4 w = *reinterpret_cast<const u32x4*>(kp + col);
      float v[8]; float ss = 0.f;
#pragma unroll
      for (int j = 0; j < 4; ++j) { v[2 * j] = bflo(w[j]); v[2 * j + 1] = bfhi(w[j]); ss += v[2 * j] * v[2 * j] + v[2 * j + 1] * v[2 * j + 1]; }
      ss += __shfl_xor(ss, 1, 64); ss += __shfl_xor(ss, 2, 64); ss += __shfl_xor(ss, 4, 64); ss += __shfl_xor(ss, 8, 64);
      const float rr = rsqrtf(ss * (1.f / 128.f) + EPS);
      const int d = col & 127;
#pragma unroll
      for (int j = 0; j < 8; ++j) v[j] *= rr * gn[d + j];
      *reinterpret_cast<u32x4*>(kp + col) = u32x4{cvtpk(v[0], v[1]), cvtpk(v[2], v[3]), cvtpk(v[4], v[5]), cvtpk(v[6], v[7])};
    }
  }
}

constexpr int KVBLK = 64;
constexpr float THR = 8.f;
template <int DQK> DEVI int kswz(int row, int colB) {
  if constexpr (DQK == 128) return row * 256 + (colB ^ ((row & 7) << 4));
  else return row * 384 + (colB ^ (((row >> 1) & 7) << 4));
}
DEVI int v_st(int k, int c) { const int kk = (k & ~0xC) | ((k & 4) << 1) | ((k & 8) >> 1); return ((kk >> 3) * 4 + (c >> 5)) * 512 + ((kk & 7) * 32 + (c & 31)) * 2; }
DEVI int v_rd_base(int lane) { return ((lane & 3) << 3) | (((lane >> 2) & 3) << 6) | (((lane >> 4) & 1) << 5) | (((lane >> 5) & 1) << 8); }
constexpr int v_rd_off(int d0, int ks, int half) { return d0 * 512 + ks * 4096 + half * 2048; }
template <int OFF> DEVI s16x4 tr_read(int vb) { s16x4 r; asm volatile("ds_read_b64_tr_b16 %0, %1 offset:%2" : "=&v"(r) : "v"(vb), "i"(OFF) : "memory"); return r; }
template <int D0> DEVI void pv_one(f32x16& od, int vb, bf16x8 pa0, bf16x8 pa1, bf16x8 pa2, bf16x8 pa3) {
  const s16x4 l0 = tr_read<v_rd_off(D0, 0, 0)>(vb), h0 = tr_read<v_rd_off(D0, 0, 1)>(vb), l1 = tr_read<v_rd_off(D0, 1, 0)>(vb), h1 = tr_read<v_rd_off(D0, 1, 1)>(vb);
  const s16x4 l2 = tr_read<v_rd_off(D0, 2, 0)>(vb), h2 = tr_read<v_rd_off(D0, 2, 1)>(vb), l3 = tr_read<v_rd_off(D0, 3, 0)>(vb), h3 = tr_read<v_rd_off(D0, 3, 1)>(vb);
  asm volatile("s_waitcnt lgkmcnt(0)" ::: "memory"); SBAR();
#define PKV(L, H) (bf16x8){L[0], L[1], L[2], L[3], H[0], H[1], H[2], H[3]}
  od = __builtin_amdgcn_mfma_f32_32x32x16_bf16(pa0, PKV(l0, h0), od, 0, 0, 0);
  od = __builtin_amdgcn_mfma_f32_32x32x16_bf16(pa1, PKV(l1, h1), od, 0, 0, 0);
  od = __builtin_amdgcn_mfma_f32_32x32x16_bf16(pa2, PKV(l2, h2), od, 0, 0, 0);
  od = __builtin_amdgcn_mfma_f32_32x32x16_bf16(pa3, PKV(l3, h3), od, 0, 0, 0);
#undef PKV
}
DEVI void pv_d0(f32x16* o, int vb, bf16x8 pa0, bf16x8 pa1, bf16x8 pa2, bf16x8 pa3) {
  pv_one<0>(o[0], vb, pa0, pa1, pa2, pa3); pv_one<1>(o[1], vb, pa0, pa1, pa2, pa3); pv_one<2>(o[2], vb, pa0, pa1, pa2, pa3); pv_one<3>(o[3], vb, pa0, pa1, pa2, pa3);
}
template <int DQK> DEVI void partialSM(f32x16& p0, f32x16& p1, float& m_reg, float& mn, float& alpha) {
  constexpr float SCALE = (DQK == 192) ? 0.07216878364870322f : 0.08838834764831845f;
  constexpr float C = SCALE * LOG2E;
  float pmax = p0[0];
#pragma unroll
  for (int r = 1; r < 16; ++r) pmax = fmaxf(pmax, p0[r]);
#pragma unroll
  for (int r = 0; r < 16; ++r) pmax = fmaxf(pmax, p1[r]);
  pmax = swap_max(pmax);
  if (__builtin_expect(__all(pmax - m_reg <= THR / SCALE), 1)) { mn = m_reg; alpha = 1.f; }
  else { mn = fmaxf(m_reg, pmax); alpha = __builtin_amdgcn_exp2f((m_reg - mn) * C); m_reg = mn; }
  const float mnC = -mn * C;
#pragma unroll
  for (int r = 0; r < 16; ++r) p0[r] = fmaf(p0[r], C, mnC);
#pragma unroll
  for (int r = 0; r < 16; ++r) p1[r] = fmaf(p1[r], C, mnC);
#pragma unroll
  for (int r = 0; r < 16; ++r) p0[r] = __builtin_amdgcn_exp2f(p0[r]);
}
DEVI void finishSM(f32x16& p0, f32x16& p1, float alpha, float& l_reg, bf16x8& pa0, bf16x8& pa1, bf16x8& pa2, bf16x8& pa3) {
#pragma unroll
  for (int r = 0; r < 16; ++r) p1[r] = __builtin_amdgcn_exp2f(p1[r]);
  float ps = 0;
#pragma unroll
  for (int r = 0; r < 16; ++r) ps += p0[r];
#pragma unroll
  for (int r = 0; r < 16; ++r) ps += p1[r];
  ps = swap_sum(ps);
  l_reg = l_reg * alpha + ps;
  PK4(p0, 0, pa0); PK4(p0, 8, pa1); PK4(p1, 0, pa2); PK4(p1, 8, pa3);
}
template <int DQK> DEVI void qkt_acc(f32x16& p0, f32x16& p1, const char* Ks, const bf16x8* qr, int r32, int hi) {
#pragma unroll
  for (int d0 = 0; d0 < DQK / 16; ++d0) { const int cb = (d0 * 16 + hi * 8) * 2;
    const bf16x8 b0 = *reinterpret_cast<const bf16x8*>(Ks + kswz<DQK>(r32, cb));
    const bf16x8 b1 = *reinterpret_cast<const bf16x8*>(Ks + kswz<DQK>(32 + r32, cb));
    p0 = __builtin_amdgcn_mfma_f32_32x32x16_bf16(b0, qr[d0], p0, 0, 0, 0);
    p1 = __builtin_amdgcn_mfma_f32_32x32x16_bf16(b1, qr[d0], p1, 0, 0, 0); }
}
DEVI float silu_f(float g) { return g * __builtin_amdgcn_rcpf(1.f + __builtin_amdgcn_exp2f(-g * LOG2E)); }

template <int DQK, bool QNORM>
DEVI void attn_dense(const bf16* __restrict__ Qb, int ldq, const bf16* __restrict__ Kh, int ldk, const bf16* __restrict__ Vh, int ldv,
                     const bf16* __restrict__ Gb, int ldg, bf16* __restrict__ Ob, int ldo, int seq, const float* __restrict__ qgain, float negM) {
  constexpr int ND0 = DQK / 16, NCH = DQK / 8, KPT = NCH / 8;
  constexpr int SHM_V = 16384, SHM_K = 64 * DQK * 2;
  char* lds = g_smem;
  LAUNDER_TID(tid); const int wid = tid >> 6, lane = tid & 63, r32 = lane & 31, hi = lane >> 5;
  char* V_lds = lds; char* K_lds = lds + 2 * SHM_V;
  float* wsf = (float*)(lds + 2 * SHM_V + 2 * SHM_K) + wid * 64; float* li_l = wsf; float* al_l = wsf + 32;
  float l_reg = 0; f32x16 o[4] = {}; bf16x8 qr[ND0];
  const bf16* Qw = Qb + (size_t)(wid * 32 + r32) * ldq + hi * 8;
#pragma unroll
  for (int d0 = 0; d0 < ND0; ++d0) qr[d0] = *reinterpret_cast<const bf16x8*>(Qw + d0 * 16);
  if constexpr (QNORM) {
    float ss = 0.f;
#pragma unroll
    for (int d0 = 0; d0 < ND0; ++d0) { const u32x4 u = __builtin_bit_cast(u32x4, qr[d0]);
#pragma unroll
      for (int j = 0; j < 4; ++j) { const float a = bflo(u[j]), b = bfhi(u[j]); ss += a * a + b * b; } }
    ss = swap_sum(ss);
    const float rq = rsqrtf(ss * (1.f / DQK) + EPS) * (0.08838834764831845f * LOG2E);
#pragma unroll
    for (int d0 = 0; d0 < ND0; ++d0) { const u32x4 u = __builtin_bit_cast(u32x4, qr[d0]); u32x4 w;
      const f32x4 g0 = *reinterpret_cast<const f32x4*>(qgain + d0 * 16 + hi * 8), g1 = *reinterpret_cast<const f32x4*>(qgain + d0 * 16 + hi * 8 + 4);
      w[0] = cvtpk(bflo(u[0]) * rq * g0[0], bfhi(u[0]) * rq * g0[1]); w[1] = cvtpk(bflo(u[1]) * rq * g0[2], bfhi(u[1]) * rq * g0[3]);
      w[2] = cvtpk(bflo(u[2]) * rq * g1[0], bfhi(u[2]) * rq * g1[1]); w[3] = cvtpk(bflo(u[3]) * rq * g1[2], bfhi(u[3]) * rq * g1[3]);
      qr[d0] = __builtin_bit_cast(bf16x8, w); }
  }
  int kgo[KPT], vgo[2];
#pragma unroll
  for (int i = 0; i < KPT; ++i) { const int q = tid + 512 * i, row = q / NCH, chp = q % NCH;
    const int ch = (DQK == 128) ? (chp ^ (row & 7)) : (chp ^ ((row >> 1) & 7)); kgo[i] = row * ldk + ch * 8; }
#pragma unroll
  for (int i = 0; i < 2; ++i) { const int q = tid + 512 * i, st = q >> 5, kk = (st >> 2) * 8 + ((q >> 2) & 7), cc = q & 3;
    const int k = (kk & ~0xC) | ((kk & 4) << 1) | ((kk & 8) >> 1); vgo[i] = k * ldv + (st & 3) * 32 + cc * 8; }
  const int vb0 = (int)(uintptr_t)V_lds + v_rd_base(lane);
#define GLOAD(b, k0) do { const bf16* kg_ = Kh + (size_t)(k0) * ldk; const bf16* vg_ = Vh + (size_t)(k0) * ldv;               \
    _Pragma("unroll") for (int q_ = 0; q_ < KPT; ++q_) __builtin_amdgcn_global_load_lds((const unsigned*)(kg_ + kgo[q_]), (unsigned*)(K_lds + (b) * SHM_K + q_ * 8192 + tid * 16), 16, 0, 0); \
    _Pragma("unroll") for (int q_ = 0; q_ < 2; ++q_) __builtin_amdgcn_global_load_lds((const unsigned*)(vg_ + vgo[q_]), (unsigned*)(V_lds + (b) * SHM_V + q_ * 8192 + tid * 16), 16, 0, 0); } while (0)
  const int NT = seq / KVBLK;
  __syncthreads();
  GLOAD(0, 0);
  asm volatile("s_waitcnt vmcnt(0)" ::: "memory"); __syncthreads();
  for (int j = 0; j < NT; ++j) {
    const int b = j & 1;
    if (j + 1 < NT) GLOAD(b ^ 1, (j + 1) * KVBLK);
    f32x16 p0, p1; bf16x8 pa0, pa1, pa2, pa3;
#pragma unroll
    for (int r = 0; r < 16; ++r) { p0[r] = negM; p1[r] = negM; }
    qkt_acc<DQK>(p0, p1, K_lds + b * SHM_K, qr, r32, hi);
#pragma unroll
    for (int r = 0; r < 16; ++r) { p0[r] = __builtin_amdgcn_exp2f(p0[r]); p1[r] = __builtin_amdgcn_exp2f(p1[r]); }
    float ps = 0.f;
#pragma unroll
    for (int r = 0; r < 16; ++r) ps += p0[r] + p1[r];
    l_reg += ps;
    PK4(p0, 0, pa0); PK4(p0, 8, pa1); PK4(p1, 0, pa2); PK4(p1, 8, pa3);
    pv_d0(o, vb0 + b * SHM_V, pa0, pa1, pa2, pa3);
    asm volatile("s_waitcnt vmcnt(0)" ::: "memory"); __syncthreads();
  }
  l_reg = swap_sum(l_reg);
  if (hi == 0) li_l[r32] = l_reg; asm volatile("s_waitcnt lgkmcnt(0)" ::: "memory");
  const bf16* Gw = Gb + (size_t)(wid * 32) * ldg; bf16* Ow = Ob + (size_t)(wid * 32) * ldo;
#pragma unroll
  for (int r = 0; r < 16; ++r) { const int orow = crow(r, hi); const float rl = __builtin_amdgcn_rcpf(li_l[orow]);
#pragma unroll
    for (int d0 = 0; d0 < 4; ++d0) {
      const float g = __bfloat162float(Gw[(size_t)orow * ldg + d0 * 32 + r32]);
      Ow[(size_t)orow * ldo + d0 * 32 + r32] = __float2bfloat16(o[d0][r] * rl * silu_f(g));
    } }
#undef GLOAD
}

DEVI void mla_item(const Params& p, int t, float negM) {
  char* ws = p.ws; const int qb = t & 15, h = (t >> 4) & 7, b = t >> 7;
  const size_t tok0 = (size_t)b * SEQ + qb * 256, tokb = (size_t)b * SEQ;
  bf16* Q = (bf16*)(ws + OFF_Q0) + tok0 * 1536 + h * 192;
  attn_dense<192, false>(Q, 1536, (const bf16*)(ws + OFF_K0) + tokb * 1536 + h * 192, 1536, (const bf16*)(ws + OFF_V0) + tokb * 1024 + h * 128, 1024,
                         (const bf16*)p.out + tok0 * 2048 + 512 + h * 128, 2048, Q, 1536, SEQ, nullptr, negM);
}
template <int L> DEVI void mem_item(const Params& p, int t, float negM) {
  char* ws = p.ws; const int qb = t & 15, hm = (t >> 4) & 3, b = t >> 6;
  const size_t tok0 = (size_t)b * SEQ + qb * 256;
  const bf16* zb = (L == 0 ? (const bf16*)p.out : (const bf16*)(ws + OFF_Z1B)) + tok0 * 2048;
  const bf16* kv = (const bf16*)(ws + OFF_MEMKV + (size_t)L * MEMKV_BYTES) + (size_t)b * 256 * 1024 + hm * 128;
  bf16* mo = (bf16*)(ws + (L == 0 ? OFF_MEMO0 : OFF_MEMO1)) + tok0 * 512 + hm * 128;
  attn_dense<128, true>(zb + hm * 128, 2048, kv, 1024, kv + 512, 1024, zb + 512 + 1024 + hm * 128, 2048, mo, 512, 256, p.mem_q_norm + L * 128, negM);
}
DEVI float softmax_shift(const float* __restrict__ gq, const float* __restrict__ gk, int n) {
  float mq = 0.f, mk = 0.f;
  cfloat_p cq = (cfloat_p)(uintptr_t)gq, ck = (cfloat_p)(uintptr_t)gk;
  for (int i = 0; i < n; ++i) { mq = fmaxf(mq, fabsf(cq[i])); mk = fmaxf(mk, fabsf(ck[i])); }
  return -LOG2E * sqrtf((float)n) * mq * mk;
}
DEVI void phase_attn0(const Params& p) {
  const float negM_mla = softmax_shift(p.a_q_norm, p.a_k_norm, 192), negM_mem = softmax_shift(p.mem_q_norm, p.mem_k_norm, 128);
  constexpr int NJ = 1536 + 768;
  for (int it = 0;; ++it) {
    const int t = remap_tile(it); if (it * (int)gridDim.x >= NJ) break; if (t >= NJ) continue;
    if (t < 1536) mla_item(p, t, negM_mla); else mem_item<0>(p, t - 1536, negM_mem);
  }
}

DEVI void phase_knorm(const Params& p) {
  char* ws = p.ws; const bf16* z = (const bf16*)(ws + OFF_Z1A); bf16* kn = (bf16*)(ws + OFF_KN);
  LAUNDER_TID(tid);
  const long gt = (long)blockIdx.x * 512 + tid, gsz = (long)gridDim.x * 512;
  for (long i = gt; i < (long)NTOK * 16; i += gsz) {
    const long tok = i >> 4; const int c = (int)(i & 15) * 8;
    const u32x4 w = *reinterpret_cast<const u32x4*>(z + tok * 1280 + 1024 + c);
    float v[8]; float ss = 0.f;
#pragma unroll
    for (int j = 0; j < 4; ++j) { v[2 * j] = bflo(w[j]); v[2 * j + 1] = bfhi(w[j]); ss += v[2 * j] * v[2 * j] + v[2 * j + 1] * v[2 * j + 1]; }
    ss += __shfl_xor(ss, 1, 64); ss += __shfl_xor(ss, 2, 64); ss += __shfl_xor(ss, 4, 64);
    const float rr = rsqrtf(ss * (1.f / 64.f) + EPS);
    const int d = c & 63;
#pragma unroll
    for (int j = 0; j < 8; ++j) v[j] *= rr * p.b_k_norm[d + j];
    *reinterpret_cast<u32x4*>(kn + tok * 128 + c) = u32x4{cvtpk(v[0], v[1]), cvtpk(v[2], v[3]), cvtpk(v[4], v[5]), cvtpk(v[6], v[7])};
  }
}

constexpr int v_rd_off64(int d0, int ks, int half) { return ((2 * ks + half) * 2 + d0) * 512; }
template <int KS> DEVI void pv_ks64(f32x16* o, int vb, bf16x8 pa) {
  const s16x4 l0 = tr_read<v_rd_off64(0, KS, 0)>(vb), h0 = tr_read<v_rd_off64(0, KS, 1)>(vb), l1 = tr_read<v_rd_off64(1, KS, 0)>(vb), h1 = tr_read<v_rd_off64(1, KS, 1)>(vb);
  asm volatile("s_waitcnt lgkmcnt(0)" ::: "memory"); SBAR();
#define PKV(L, H) (bf16x8){L[0], L[1], L[2], L[3], H[0], H[1], H[2], H[3]}
  o[0] = __builtin_amdgcn_mfma_f32_32x32x16_bf16(pa, PKV(l0, h0), o[0], 0, 0, 0);
  o[1] = __builtin_amdgcn_mfma_f32_32x32x16_bf16(pa, PKV(l1, h1), o[1], 0, 0, 0);
#undef PKV
}
DEVI void swa_item(const Params& p, int t, float bound2) {
  char* ws = p.ws; LAUNDER_PTR(ws); char* lds = g_smem;
  const int qc = t & 127, kvh = (t >> 7) & 1, b = t >> 8;
  LAUNDER_TID(tid); const int wid = tid >> 6, lane = tid & 63, r32 = lane & 31, hi = lane >> 5;
  const int hq = kvh * 8 + wid, i0 = qc * 32; const size_t tokb = (size_t)b * SEQ;
  bf16* z1a = (bf16*)(ws + OFF_Z1A); const bf16* kn = (const bf16*)(ws + OFF_KN); const bf16* z1b = (const bf16*)(ws + OFF_Z1B);
  char* K_lds = lds; char* V_lds = lds + 5 * 8192; float* li_l = (float*)(lds + 10 * 8192) + wid * 64;
  const int ts0 = (i0 - 128) & ~63;
  const int jlo = ts0 < 0 ? (-ts0) >> 6 : 0, jhi = min(5, (SEQ - ts0) >> 6);
  __syncthreads();
  {
    const int krow = tid >> 3, kch = (tid & 7) ^ ((krow >> 1) & 7);
    const int st = tid >> 5, kk = (st >> 1) * 8 + ((tid >> 2) & 7), vk = (kk & ~0xC) | ((kk & 4) << 1) | ((kk & 8) >> 1), vcol = (st & 1) * 32 + (tid & 3) * 8;
    const bf16* kg = kn + (tokb + ts0 + krow) * 128 + kvh * 64 + kch * 8;
    const bf16* vg = z1a + (tokb + ts0 + vk) * 1280 + 1152 + kvh * 64 + vcol;
    for (int j = jlo; j < jhi; ++j) {
      __builtin_amdgcn_global_load_lds((const unsigned*)(kg + (size_t)j * 64 * 128), (unsigned*)(K_lds + j * 8192 + tid * 16), 16, 0, 0);
      __builtin_amdgcn_global_load_lds((const unsigned*)(vg + (size_t)j * 64 * 1280), (unsigned*)(V_lds + j * 8192 + tid * 16), 16, 0, 0);
    }
  }
  const bf16* Gw = z1b + (tokb + i0) * 2048 + 512 + hq * 64 + r32;
  unsigned gpk[16];
#pragma unroll
  for (int r = 0; r < 16; ++r) { const int orow = crow(r, hi);
    const unsigned g0 = *reinterpret_cast<const unsigned short*>(Gw + (size_t)orow * 2048), g1 = *reinterpret_cast<const unsigned short*>(Gw + (size_t)orow * 2048 + 32);
    gpk[r] = g0 | (g1 << 16); }
  bf16* Qw = z1a + (tokb + i0 + r32) * 1280 + hq * 64;
  bf16x8 qr[4];
  { float ss = 0.f; u32x4 u[4];
#pragma unroll
    for (int d0 = 0; d0 < 4; ++d0) { u[d0] = *reinterpret_cast<const u32x4*>(Qw + d0 * 16 + hi * 8);
#pragma unroll
      for (int j = 0; j < 4; ++j) { const float a = bflo(u[d0][j]), c = bfhi(u[d0][j]); ss += a * a + c * c; } }
    ss = swap_sum(ss);
    const float rq = rsqrtf(ss * (1.f / 64.f) + EPS) * (0.125f * LOG2E);
#pragma unroll
    for (int d0 = 0; d0 < 4; ++d0) { u32x4 w;
      const f32x4 g0 = *reinterpret_cast<const f32x4*>(p.b_q_norm + d0 * 16 + hi * 8), g1 = *reinterpret_cast<const f32x4*>(p.b_q_norm + d0 * 16 + hi * 8 + 4);
      w[0] = cvtpk(bflo(u[d0][0]) * rq * g0[0], bfhi(u[d0][0]) * rq * g0[1]); w[1] = cvtpk(bflo(u[d0][1]) * rq * g0[2], bfhi(u[d0][1]) * rq * g0[3]);
      w[2] = cvtpk(bflo(u[d0][2]) * rq * g1[0], bfhi(u[d0][2]) * rq * g1[1]); w[3] = cvtpk(bflo(u[d0][3]) * rq * g1[2], bfhi(u[d0][3]) * rq * g1[3]);
      qr[d0] = __builtin_bit_cast(bf16x8, w); }
  }
  const float slope2 = exp2f(-0.5f * (float)(hq + 1)) * LOG2E, sink2 = p.b_sink[hq] * LOG2E;
  const float negM = -fmaxf(bound2, sink2);
  float l_reg = 0.f;
  f32x16 o[2] = {};
  const int vb0 = (int)(uintptr_t)V_lds + v_rd_base(lane);
  const int query = i0 + r32;
  asm volatile("s_waitcnt vmcnt(0)" ::: "memory"); __syncthreads();
  for (int j = jlo; j < jhi; ++j) {
    const int ts = ts0 + 64 * j; const char* Kt = K_lds + j * 8192;
    f32x16 p0, p1;
#pragma unroll
    for (int r = 0; r < 16; ++r) { p0[r] = negM; p1[r] = negM; }
#pragma unroll
    for (int d0 = 0; d0 < 4; ++d0) { const int ch = d0 * 2 + hi;
      const bf16x8 b0 = *reinterpret_cast<const bf16x8*>(Kt + swz128(r32, ch));
      const bf16x8 b1 = *reinterpret_cast<const bf16x8*>(Kt + swz128(32 + r32, ch));
      p0 = __builtin_amdgcn_mfma_f32_32x32x16_bf16(b0, qr[d0], p0, 0, 0, 0);
      p1 = __builtin_amdgcn_mfma_f32_32x32x16_bf16(b1, qr[d0], p1, 0, 0, 0); }
    const float fb0 = (float)(ts - query + 4 * hi), fb1 = fb0 + 32.f;
    const bool full = (ts - (i0 + 31) >= -128) && (ts + 63 - i0 <= 128);
    float ps = 0.f;
    if (full) {
#pragma unroll
      for (int r = 0; r < 16; ++r) { const float off = (float)((r & 3) + 8 * (r >> 2));
        p0[r] = __builtin_amdgcn_exp2f(fmaf(-slope2, fabsf(fb0 + off), p0[r]));
        p1[r] = __builtin_amdgcn_exp2f(fmaf(-slope2, fabsf(fb1 + off), p1[r]));
        ps += p0[r] + p1[r]; }
    } else {
#pragma unroll
      for (int r = 0; r < 16; ++r) { const float off = (float)((r & 3) + 8 * (r >> 2));
        const float e0 = fabsf(fb0 + off), e1 = fabsf(fb1 + off);
        p0[r] = e0 <= 128.f ? __builtin_amdgcn_exp2f(fmaf(-slope2, e0, p0[r])) : 0.f;
        p1[r] = e1 <= 128.f ? __builtin_amdgcn_exp2f(fmaf(-slope2, e1, p1[r])) : 0.f;
        ps += p0[r] + p1[r]; }
    }
    l_reg += ps;
    const int vb = vb0 + j * 8192; bf16x8 pa;
    PK4(p0, 0, pa); pv_ks64<0>(o, vb, pa); PK4(p0, 8, pa); pv_ks64<1>(o, vb, pa);
    PK4(p1, 0, pa); pv_ks64<2>(o, vb, pa); PK4(p1, 8, pa); pv_ks64<3>(o, vb, pa);
  }
  l_reg = swap_sum(l_reg) + __builtin_amdgcn_exp2f(sink2 + negM);
  if (hi == 0) li_l[r32] = l_reg; asm volatile("s_waitcnt lgkmcnt(0)" ::: "memory");
  bf16* Ow = z1a + (tokb + i0) * 1280 + hq * 64 + r32;
#pragma unroll
  for (int r = 0; r < 16; ++r) { const int orow = crow(r, hi); const float rl = __builtin_amdgcn_rcpf(li_l[orow]);
    Ow[(size_t)orow * 1280] = __float2bfloat16(o[0][r] * rl * silu_f(bflo(gpk[r])));
    Ow[(size_t)orow * 1280 + 32] = __float2bfloat16(o[1][r] * rl * silu_f(bfhi(gpk[r])));
  }
}
DEVI void phase_attn1(const Params& p) {
  const float negM_mem = softmax_shift(p.mem_q_norm + 128, p.mem_k_norm + 128, 128), bound2_swa = -softmax_shift(p.b_q_norm, p.b_k_norm, 64);
  constexpr int NJ = 3072 + 768;
  for (int it = 0;; ++it) {
    const int t = remap_tile(it); if (it * (int)gridDim.x >= NJ) break; if (t >= NJ) continue;
    if (t < 768) mem_item<1>(p, t, negM_mem); else swa_item(p, t - 768, bound2_swa);
  }
}

DEVI void grid_barrier(unsigned* ctr, unsigned target) {
  asm volatile("s_waitcnt vmcnt(0)" ::: "memory");
  __syncthreads();
  if (threadIdx.x == 0) {
    __builtin_amdgcn_fence(__ATOMIC_RELEASE, "agent");
    asm volatile("s_waitcnt vmcnt(0)" ::: "memory");
    (void)__hip_atomic_fetch_add(ctr, 1u, __ATOMIC_RELAXED, __HIP_MEMORY_SCOPE_AGENT);
    unsigned sp = 0;
    while (__hip_atomic_load(ctr, __ATOMIC_RELAXED, __HIP_MEMORY_SCOPE_AGENT) < target) { __builtin_amdgcn_s_sleep(1); if (++sp > (1u << 22)) break; }
    __builtin_amdgcn_fence(__ATOMIC_ACQUIRE, "agent");
    asm volatile("s_waitcnt vmcnt(0)" ::: "memory");
  }
  __syncthreads();
}
template <int PH> DEVI void run_phase(const Params& p) {
  if constexpr (PH == 0) phase_prep(p);
  else if constexpr (PH == 1) phase_gemm1(p);
  else if constexpr (PH == 2) phase_p2(p);
  else if constexpr (PH == 3) phase_attn0(p);
  else if constexpr (PH == 4) phase_gemm_simple<G_OUT0>(p, 4);
  else if constexpr (PH == 5) phase_gemm_simple<G_Z1>(p, 13);
  else if constexpr (PH == 6) phase_knorm(p);
  else if constexpr (PH == 7) phase_attn1(p);
  else phase_gemm_simple<G_OUT1>(p, 4);
}
#if MK_COOP
__global__ __launch_bounds__(512) void mega_coop(Params p) {
  cg::grid_group grid = cg::this_grid();
  unsigned* bctr = (unsigned*)(p.ws + OFF_BAR); const unsigned G = gridDim.x;
  phase_prep(p); grid.sync();
  phase_gemm1(p); grid_barrier(bctr, 1 * G);
  phase_p2(p); grid_barrier(bctr, 2 * G);
  phase_attn0(p); grid_barrier(bctr, 3 * G);
  phase_gemm_simple<G_OUT0>(p, 4); grid_barrier(bctr, 4 * G);
  phase_gemm_simple<G_Z1>(p, 13); grid_barrier(bctr, 5 * G);
  phase_knorm(p); grid_barrier(bctr, 6 * G);
  phase_attn1(p); grid_barrier(bctr, 7 * G);
  phase_gemm_simple<G_OUT1>(p, 4);
}
#endif
template <int PH> __global__ __launch_bounds__(512) void mega_phase(Params p) { run_phase<PH>(p); }

extern "C" void kernel_launch(void* const* d_in, const int* in_sizes, int n_in, void* d_out, int out_size, void* d_ws, size_t ws_size, hipStream_t stream) {
  static int grid = 0;
  if (grid == 0) {
    if (n_in != 21 || out_size != NTOK * 1024 || ws_size < WS_NEED) { fprintf(stderr, "kernel_launch: unexpected shapes n_in %d out %d ws %zu\n", n_in, out_size, ws_size); grid = -1; return; }
    int dev = 0, cus = 0, per_cu = 0;
    (void)hipGetDevice(&dev); (void)hipDeviceGetAttribute(&cus, hipDeviceAttributeMultiprocessorCount, dev);
#if MK_COOP
    (void)hipFuncSetAttribute((const void*)mega_coop, hipFuncAttributeMaxDynamicSharedMemorySize, LDS_BYTES);
    (void)hipOccupancyMaxActiveBlocksPerMultiprocessor(&per_cu, (const void*)mega_coop, 512, LDS_BYTES);
#else
#define SETATTR(PH) (void)hipFuncSetAttribute((const void*)mega_phase<PH>, hipFuncAttributeMaxDynamicSharedMemorySize, LDS_BYTES)
    SETATTR(0); SETATTR(1); SETATTR(2); SETATTR(3); SETATTR(4); SETATTR(5); SETATTR(6); SETATTR(7); SETATTR(8);
    per_cu = 1;
#endif
    if (per_cu < 1) { fprintf(stderr, "kernel_launch: occupancy query says %d blocks/CU\n", per_cu); per_cu = 1; }
    grid = cus * 1;
  }
  if (grid < 0) return;
  { static const int exp_sz[21] = {8*4096*1024, 4*4096*1024, 8*256*1024, 4*256*1024, 2*1024, 2*1536*1024, 2*1024, 2*1024*1024, 2*128, 2*128,
      1024*2752, 384, 384*1536, 256, 256*2048, 192, 192, 1024*3328, 64, 64, 16};
    for (int i = 0; i < 21; ++i) if (in_sizes[i] != exp_sz[i]) { fprintf(stderr, "in_sizes[%d] = %d != %d\n", i, in_sizes[i], exp_sz[i]);
      return; } }
  Params p{};
  const float** pp = (const float**)&p;
  for (int i = 0; i < 21; ++i) pp[i] = (const float*)d_in[i];
  p.out = (float*)d_out; p.ws = (char*)d_ws;
#if MK_COOP
  (void)hipMemsetAsync((char*)d_ws + OFF_BAR, 0, 256, stream);
  void* args[] = {&p};
  hipError_t e = hipLaunchCooperativeKernel((const void*)mega_coop, dim3(grid), dim3(512), args, LDS_BYTES, stream);
  if (e != hipSuccess) fprintf(stderr, "cooperative launch failed: %s (grid %d)\n", hipGetErrorString(e), grid);
#else
#define LAUNCH(PH) hipLaunchKernelGGL(mega_phase<PH>, dim3(grid), dim3(512), LDS_BYTES, stream, p)
  LAUNCH(0); LAUNCH(1); LAUNCH(2); LAUNCH(3); LAUNCH(4); LAUNCH(5); LAUNCH(6); LAUNCH(7); LAUNCH(8);
#endif
}
```

```cpp
#include <hip/hip_runtime.h>
#include <hip/hip_bf16.h>
#include <hip/hip_cooperative_groups.h>
#include <cstdio>
#include <cstdint>
namespace cg = cooperative_groups;

#ifndef MK_COOP
#define MK_COOP 1
#endif

using bf16   = __hip_bfloat16;
using bf16x8 = __attribute__((ext_vector_type(8))) short;
using s16x4  = __attribute__((ext_vector_type(4))) short;
using f32x16 = __attribute__((ext_vector_type(16))) float;
using f32x4  = __attribute__((ext_vector_type(4))) float;
using u32x4  = __attribute__((ext_vector_type(4))) unsigned;
using u32x2  = __attribute__((ext_vector_type(2))) unsigned;
using bf2_t  = __attribute__((ext_vector_type(2))) __bf16;
#define DEVI __device__ __forceinline__
typedef const __attribute__((address_space(4))) float* cfloat_p;
#define SBAR() __builtin_amdgcn_sched_barrier(0)
#define LAUNDER_TID(tid) int tid = threadIdx.x; asm volatile("" : "+v"(tid))
#define LAUNDER_PTR(ptr) asm volatile("" : "+s"(ptr))

constexpr int NTOK = 49152, SEQ = 4096, NPROMPT_TOK = 32768;
constexpr int NMEMROW = 3072, NPROMPT_MEM = 2048;
constexpr float EPS = 1e-6f;
constexpr float LOG2E = 1.4426950408889634f;

constexpr size_t MiB = 1ull << 20;
constexpr size_t WA_BYTES = 2816ull * 1024 * 2, WB_BYTES = 3328ull * 1024 * 2, WO_BYTES = 1024ull * 1536 * 2, WM_BYTES = 1024ull * 1024 * 2;
constexpr size_t WQ_BYTES = 1536ull * 384 * 2, WKV_BYTES = 2048ull * 256 * 2, MEMKV_BYTES = 3072ull * 1024 * 2;
constexpr size_t OFF_WA = 0;
constexpr size_t OFF_WB = OFF_WA + WA_BYTES;
constexpr size_t OFF_WO = OFF_WB + WB_BYTES;
constexpr size_t OFF_WM = OFF_WO + 2 * WO_BYTES;
constexpr size_t OFF_WQ = OFF_WM + 2 * WM_BYTES;
constexpr size_t OFF_WKV = OFF_WQ + WQ_BYTES;
constexpr size_t OFF_MEMKV = OFF_WKV + WKV_BYTES;
constexpr size_t OFF_MEMB = OFF_MEMKV + 2 * MEMKV_BYTES;
constexpr size_t OFF_SS0 = OFF_MEMB + 3072ull * 1024 * 2;
constexpr size_t OFF_SS1 = OFF_SS0 + NTOK * 4ull;
constexpr size_t OFF_SSM = OFF_SS1 + NTOK * 4ull;
constexpr size_t OFF_ROPE = OFF_SSM + NMEMROW * 4ull;
constexpr size_t OFF_W_END = OFF_ROPE + 2ull * 4096 * 32 * 4;
constexpr size_t OFF_BAR = 60 * MiB - 16384;
static_assert(OFF_W_END <= OFF_BAR, "weight region overflow");
constexpr size_t OFF_XB = 60 * MiB, OFF_Q0 = 60 * MiB, OFF_K0 = 204 * MiB, OFF_V0 = 348 * MiB, OFF_ZA = 446 * MiB, OFF_MEMO0 = 446 * MiB;
constexpr size_t OFF_X1B = 204 * MiB, OFF_Z1A = 60 * MiB, OFF_KN = 180 * MiB, OFF_MEMO1 = 204 * MiB, OFF_Z1B = 300 * MiB;
constexpr size_t WS_NEED = 512 * MiB;

struct Params {
  const float *x_prompt, *x_sample, *mem_prompt, *mem_sample, *norm_in, *w_out, *mem_norm, *w_mem_kv, *mem_q_norm, *mem_k_norm;
  const float *a_w_in, *a_q_a_norm, *a_w_q_b, *a_kv_a_norm, *a_w_kv_b, *a_q_norm, *a_k_norm, *b_w_in, *b_q_norm, *b_k_norm, *b_sink;
  float* out; char* ws;
};

extern __shared__ __attribute__((aligned(16))) char g_smem[];
constexpr int LDS_BYTES = 131072;

DEVI int crow(int r, int hi) { return (r & 3) + 8 * (r >> 2) + 4 * hi; }
DEVI unsigned cvtpk(float lo, float hi) { unsigned r; asm volatile("v_cvt_pk_bf16_f32 %0, %1, %2" : "=v"(r) : "v"(lo), "v"(hi)); return r; }
DEVI float bflo(unsigned w) { return __uint_as_float(w << 16); }
DEVI float bfhi(unsigned w) { return __uint_as_float(w & 0xffff0000u); }
DEVI float swap_sum(float v) { auto rr = __builtin_amdgcn_permlane32_swap(__float_as_uint(v), __float_as_uint(v), false, false); return __uint_as_float(rr[0]) + __uint_as_float(rr[1]); }
DEVI float swap_max(float v) { auto rr = __builtin_amdgcn_permlane32_swap(__float_as_uint(v), __float_as_uint(v), false, false); return fmaxf(__uint_as_float(rr[0]), __uint_as_float(rr[1])); }
#define PK4(P, BASE, OUT) do { unsigned a0_ = cvtpk(P[BASE + 0], P[BASE + 1]), a1_ = cvtpk(P[BASE + 2], P[BASE + 3]);   \
    unsigned b0_ = cvtpk(P[BASE + 4], P[BASE + 5]), b1_ = cvtpk(P[BASE + 6], P[BASE + 7]);                              \
    auto r0_ = __builtin_amdgcn_permlane32_swap(a0_, b0_, false, false); auto r1_ = __builtin_amdgcn_permlane32_swap(a1_, b1_, false, false); \
    u32x4 w_ = {r0_[0], r1_[0], r0_[1], r1_[1]}; OUT = __builtin_bit_cast(bf16x8, w_); } while (0)
DEVI const float* x_row(const Params& p, int tok) { return tok < NPROMPT_TOK ? p.x_prompt + (size_t)tok * 1024 : p.x_sample + (size_t)(tok - NPROMPT_TOK) * 1024; }
DEVI const float* mem_row(const Params& p, int r) { return r < NPROMPT_MEM ? p.mem_prompt + (size_t)r * 1024 : p.mem_sample + (size_t)(r - NPROMPT_MEM) * 1024; }
DEVI int remap_tile(int it) {
  const int G = gridDim.x, b = blockIdx.x;
  return (G & 7) ? it * G + b : it * G + (b & 7) * (G >> 3) + (b >> 3);
}

DEVI void wt_job(const float* __restrict__ W, const float* __restrict__ g, bf16* __restrict__ out, int K, int N, int Npad, long gt, long gsz) {
  const int nq = Npad >> 2; const long total = (long)nq * (K >> 3);
  for (long i = gt; i < total; i += gsz) {
    const int n4 = (int)(i % nq) << 2; const int k0 = (int)(i / nq) << 3;
    f32x4 v[8];
    if (n4 < N) {
#pragma unroll
      for (int j = 0; j < 8; ++j) { v[j] = *reinterpret_cast<const f32x4*>(W + (size_t)(k0 + j) * N + n4); const float gj = g ? g[k0 + j] : 1.f; v[j][0] *= gj; v[j][1] *= gj; v[j][2] *= gj; v[j][3] *= gj; }
    } else {
#pragma unroll
      for (int j = 0; j < 8; ++j) v[j] = f32x4{0.f, 0.f, 0.f, 0.f};
    }
#pragma unroll
    for (int c = 0; c < 4; ++c)
      *reinterpret_cast<u32x4*>(out + (size_t)(n4 + c) * K + k0) = u32x4{cvtpk(v[0][c], v[1][c]), cvtpk(v[2][c], v[3][c]), cvtpk(v[4][c], v[5][c]), cvtpk(v[6][c], v[7][c])};
  }
}
DEVI void row_job4(const Params& p, int r0, int lane) {
  char* ws = p.ws;
  f32x4 v[4][4];
#pragma unroll
  for (int k = 0; k < 4; ++k) { const int r = r0 + k;
    const float* src = r < NTOK ? x_row(p, r) : mem_row(p, r - NTOK);
#pragma unroll
    for (int i = 0; i < 2; ++i) { v[k][2 * i] = *reinterpret_cast<const f32x4*>(src + lane * 8 + 512 * i); v[k][2 * i + 1] = *reinterpret_cast<const f32x4*>(src + lane * 8 + 512 * i + 4); } }
#pragma unroll
  for (int k = 0; k < 4; ++k) { const int r = r0 + k;
    bf16* dst = r < NTOK ? (bf16*)(ws + OFF_XB) + (size_t)r * 1024 : (bf16*)(ws + OFF_MEMB) + (size_t)(r - NTOK) * 1024;
    float ss = 0.f;
#pragma unroll
    for (int i = 0; i < 2; ++i) { const f32x4 a = v[k][2 * i], c = v[k][2 * i + 1];
      ss += a[0] * a[0] + a[1] * a[1] + a[2] * a[2] + a[3] * a[3] + c[0] * c[0] + c[1] * c[1] + c[2] * c[2] + c[3] * c[3];
      *reinterpret_cast<u32x4*>(dst + lane * 8 + 512 * i) = u32x4{cvtpk(a[0], a[1]), cvtpk(a[2], a[3]), cvtpk(c[0], c[1]), cvtpk(c[2], c[3])}; }
#pragma unroll
    for (int o = 32; o > 0; o >>= 1) ss += __shfl_xor(ss, o, 64);
    if (lane == 0) { if (r < NTOK) ((float*)(ws + OFF_SS0))[r] = ss; else ((float*)(ws + OFF_SSM))[r - NTOK] = ss; }
  }
}
DEVI void phase_prep(const Params& p) {
  char* ws = p.ws; LAUNDER_TID(tid);
  const long gt = (long)blockIdx.x * 512 + tid, gsz = (long)gridDim.x * 512;
  wt_job(p.a_w_in, p.norm_in, (bf16*)(ws + OFF_WA), 1024, 2752, 2816, gt, gsz);
  wt_job(p.b_w_in, p.norm_in + 1024, (bf16*)(ws + OFF_WB), 1024, 3328, 3328, gt, gsz);
  wt_job(p.w_out, nullptr, (bf16*)(ws + OFF_WO), 1536, 1024, 1024, gt, gsz);
  wt_job(p.w_out + 1536 * 1024, nullptr, (bf16*)(ws + OFF_WO + WO_BYTES), 1536, 1024, 1024, gt, gsz);
  wt_job(p.w_mem_kv, p.mem_norm, (bf16*)(ws + OFF_WM), 1024, 1024, 1024, gt, gsz);
  wt_job(p.w_mem_kv + 1024 * 1024, p.mem_norm + 1024, (bf16*)(ws + OFF_WM + WM_BYTES), 1024, 1024, 1024, gt, gsz);
  wt_job(p.a_w_q_b, p.a_q_a_norm, (bf16*)(ws + OFF_WQ), 384, 1536, 1536, gt, gsz);
  wt_job(p.a_w_kv_b, p.a_kv_a_norm, (bf16*)(ws + OFF_WKV), 256, 2048, 2048, gt, gsz);
  float* rc = (float*)(ws + OFF_ROPE); float* rs = rc + 4096 * 32;
  for (long i = gt; i < 4096 * 32; i += gsz) {
    const int pos = (int)(i >> 5), f = (int)(i & 31);
    const float inv = exp2f(-(float)f * (13.287712379549449f / 32.f));
    float rev = (float)pos * inv * 0.15915494309189535f; rev -= floorf(rev);
    rc[i] = __builtin_amdgcn_cosf(rev); rs[i] = __builtin_amdgcn_sinf(rev);
  }
  float* ss1 = (float*)(ws + OFF_SS1);
  for (long i = gt; i < NTOK; i += gsz) ss1[i] = 0.f;
  const int wid = tid >> 6, lane = tid & 63;
  const int nw = gridDim.x * 8;
  for (int r = (blockIdx.x * 8 + wid) * 4; r < NTOK + NMEMROW; r += nw * 4) row_job4(p, r, lane);
}

enum { G_Z0 = 0, G_MKV0 = 1, G_MKV1 = 2, G_OUT0 = 3, G_Z1 = 4, G_OUT1 = 5 };
constexpr int BK = 64, HALF = 128, HT = HALF * BK;
DEVI int lds_byte(int r, int c) { int st = (r >> 4) * 2 + (c >> 5), rr = r & 15, cc = c & 31, ob = rr * 64 + cc * 2; return st * 1024 + (ob ^ (((ob >> 9) & 1) << 5)); }
DEVI void stage_rc(int b, int& R, int& C) { int st = b / 1024, sb = b % 1024, swz = sb ^ (((sb >> 9) & 1) << 5); R = (st >> 1) * 16 + swz / 64; C = (st & 1) * 32 + (swz % 64) / 2; }

template <int MODE> DEVI const bf16* a_ptr(const Params& p, int kt, int& lda) {
  char* ws = p.ws; const int k = kt * 64;
  if constexpr (MODE == G_Z0) { lda = 1024; return (const bf16*)(ws + OFF_XB) + k; }
  else if constexpr (MODE == G_MKV0 || MODE == G_MKV1) { lda = 1024; return (const bf16*)(ws + OFF_MEMB) + k; }
  else if constexpr (MODE == G_Z1) { lda = 1024; return (const bf16*)(ws + OFF_X1B) + k; }
  else if constexpr (MODE == G_OUT0) {
    if (k < 1024) { lda = 1536; return (const bf16*)(ws + OFF_Q0) + (k >> 7) * 192 + (k & 127); }
    lda = 512; return (const bf16*)(ws + OFF_MEMO0) + (k - 1024);
  } else {
    if (k < 1024) { lda = 1280; return (const bf16*)(ws + OFF_Z1A) + k; }
    lda = 512; return (const bf16*)(ws + OFF_MEMO1) + (k - 1024);
  }
}

template <int MODE>
DEVI void gemm_tile(const Params& p, int pm, int pn) {
  constexpr int K = (MODE == G_OUT0 || MODE == G_OUT1) ? 1536 : 1024;
  constexpr int nt = K / BK;
  char* ws = p.ws; LAUNDER_TID(tid);
  const bf16* Bt = (const bf16*)(ws + (MODE == G_Z0 ? OFF_WA : MODE == G_MKV0 ? OFF_WM : MODE == G_MKV1 ? OFF_WM + WM_BYTES : MODE == G_OUT0 ? OFF_WO : MODE == G_Z1 ? OFF_WB : OFF_WO + WO_BYTES));
  bf16* shm = (bf16*)g_smem;
  const int brow = pm * 256, bcol = pn * 256;
#define SA(b, h) (shm + ((b) * 2 + (h)) * HT)
#define SB(b, h) (shm + (4 + (b) * 2 + (h)) * HT)
#define STAGE_B(P, half, kt) do { const bf16* _g = Bt + (size_t)(bcol + (half) * HALF) * K + (size_t)(kt) * BK;              \
    _Pragma("unroll") for (int _i = 0; _i < 2; ++_i)                                                                          \
      __builtin_amdgcn_global_load_lds((const unsigned*)(_g + ((st_rc[_i] & 255) * K + (st_rc[_i] >> 8))), (unsigned*)((char*)(P) + tid * 16 + _i * 8192), 16, 0, 0); } while (0)
#define STAGE_A(P, half, kt) do { int _lda; const bf16* _g = a_ptr<MODE>(p, (kt), _lda) + (size_t)(brow + (half) * HALF) * _lda; \
    _Pragma("unroll") for (int _i = 0; _i < 2; ++_i)                                                                          \
      __builtin_amdgcn_global_load_lds((const unsigned*)(_g + ((st_rc[_i] & 255) * _lda + (st_rc[_i] >> 8))), (unsigned*)((char*)(P) + tid * 16 + _i * 8192), 16, 0, 0); } while (0)
#define LDA(dst, b, h) for (int m = 0; m < 4; ++m) for (int k = 0; k < 2; ++k) \
    dst[m][k] = *reinterpret_cast<const bf16x8*>((char*)SA(b, h) + lds_byte(wr * 64 + m * 16 + fr, k * 32 + fq * 8))
#define LDB(dst, b, h) for (int n = 0; n < 2; ++n) for (int k = 0; k < 2; ++k) \
    dst[n][k] = *reinterpret_cast<const bf16x8*>((char*)SB(b, h) + lds_byte(wc * 32 + n * 16 + fr, k * 32 + fq * 8))
#define MMA(ai, bj, At_, Bt_) do { __builtin_amdgcn_s_setprio(1); \
    for (int m = 0; m < 4; ++m) for (int n = 0; n < 2; ++n) for (int k = 0; k < 2; ++k) \
      acc[ai][bj][m][n] = __builtin_amdgcn_mfma_f32_16x16x32_bf16(Bt_[n][k], At_[m][k], acc[ai][bj][m][n], 0, 0, 0); \
    __builtin_amdgcn_s_setprio(0); } while (0)
#define WAIT_V(n) asm volatile("s_waitcnt vmcnt(" #n ")" ::: "memory")
#define WAIT_L(n) asm volatile("s_waitcnt lgkmcnt(" #n ")" ::: "memory")
#define BAR __builtin_amdgcn_s_barrier()
  const int wid = tid >> 6, lane = tid & 63, wr = wid >> 2, wc = wid & 3, fr = lane & 15, fq = lane >> 4;
  f32x4 acc[2][2][4][2] = {};
  bf16x8 At[4][2], B0[2][2], B1[2][2];
  int st_rc[2];
#pragma unroll
  for (int i = 0; i < 2; ++i) { int r_, c_; stage_rc(tid * 16 + i * 8192, r_, c_); st_rc[i] = r_ | (c_ << 8); }
  __syncthreads();
  STAGE_B(SB(0, 0), 0, 0); STAGE_A(SA(0, 0), 0, 0);
  STAGE_B(SB(0, 1), 1, 0); STAGE_A(SA(0, 1), 1, 0);
  if (wr == 1) BAR;
  WAIT_V(4); BAR;
  STAGE_B(SB(1, 0), 0, 1); STAGE_A(SA(1, 0), 0, 1); STAGE_B(SB(1, 1), 1, 1);
  WAIT_V(6); BAR;
  for (int t = 0; t < nt - 2; t += 2) {
    LDB(B0, 0, 0); SBAR(); LDA(At, 0, 0); STAGE_A(SA(1, 1), 1, t + 1);
    WAIT_L(8); BAR; WAIT_L(0); MMA(0, 0, At, B0); BAR; SBAR();
    LDB(B1, 0, 1); STAGE_B(SB(0, 0), 0, t + 2);
    BAR; WAIT_L(0); MMA(0, 1, At, B1); BAR;
    LDA(At, 0, 1); STAGE_A(SA(0, 0), 0, t + 2);
    BAR; WAIT_L(0); MMA(1, 0, At, B0); BAR; SBAR();
    STAGE_B(SB(0, 1), 1, t + 2);
    WAIT_V(6); BAR; MMA(1, 1, At, B1); BAR;
    LDB(B0, 1, 0); SBAR(); LDA(At, 1, 0); STAGE_A(SA(0, 1), 1, t + 2);
    WAIT_L(8); BAR; WAIT_L(0); MMA(0, 0, At, B0); BAR; SBAR();
    LDB(B1, 1, 1); STAGE_B(SB(1, 0), 0, t + 3);
    BAR; WAIT_L(0); MMA(0, 1, At, B1); BAR;
    LDA(At, 1, 1); STAGE_A(SA(1, 0), 0, t + 3);
    BAR; WAIT_L(0); MMA(1, 0, At, B0); BAR; SBAR();
    STAGE_B(SB(1, 1), 1, t + 3);
    WAIT_V(6); BAR; MMA(1, 1, At, B1); BAR;
  }
  { LDB(B0, 0, 0); LDA(At, 0, 0); STAGE_A(SA(1, 1), 1, nt - 1);
    BAR; WAIT_L(0); MMA(0, 0, At, B0); BAR;
    LDB(B1, 0, 1); BAR; WAIT_L(0); MMA(0, 1, At, B1); BAR;
    LDA(At, 0, 1); WAIT_V(4); BAR; WAIT_L(0); MMA(1, 0, At, B0); MMA(1, 1, At, B1); BAR; }
  { LDB(B0, 1, 0); LDA(At, 1, 0); WAIT_V(2); BAR; WAIT_L(0); MMA(0, 0, At, B0); BAR;
    LDB(B1, 1, 1); WAIT_V(0); BAR; WAIT_L(0); MMA(0, 1, At, B1); BAR;
    LDA(At, 1, 1); BAR; WAIT_L(0); MMA(1, 0, At, B0); MMA(1, 1, At, B1); BAR; }
  if (wr == 0) BAR;
#undef SA
#undef SB
#undef STAGE_A
#undef STAGE_B
#undef LDA
#undef LDB
#undef MMA
  float rs8[2][4];
  if constexpr (MODE == G_Z0 || MODE == G_Z1 || MODE == G_MKV0 || MODE == G_MKV1) {
    const float* ssp = (const float*)(ws + (MODE == G_Z0 ? OFF_SS0 : MODE == G_Z1 ? OFF_SS1 : OFF_SSM));
#pragma unroll
    for (int ai = 0; ai < 2; ++ai)
#pragma unroll
      for (int m = 0; m < 4; ++m) rs8[ai][m] = ssp[brow + ai * HALF + wr * 64 + m * 16 + fr];
#pragma unroll
    for (int ai = 0; ai < 2; ++ai)
#pragma unroll
      for (int m = 0; m < 4; ++m) rs8[ai][m] = rsqrtf(rs8[ai][m] * (1.f / 1024.f) + EPS);
  }
#pragma unroll
  for (int ai = 0; ai < 2; ++ai) {
    f32x4 resv[4][4];
    if constexpr (MODE == G_OUT0 || MODE == G_OUT1) {
#pragma unroll
      for (int m = 0; m < 4; ++m) { const int row = brow + ai * HALF + wr * 64 + m * 16 + fr;
        const float* res = (MODE == G_OUT0) ? x_row(p, row) : p.out + (size_t)row * 1024;
#pragma unroll
        for (int bj = 0; bj < 2; ++bj)
#pragma unroll
          for (int n = 0; n < 2; ++n) resv[m][bj * 2 + n] = *reinterpret_cast<const f32x4*>(res + bcol + bj * HALF + wc * 32 + n * 16 + fq * 4); }
    }
#pragma unroll
    for (int m = 0; m < 4; ++m) {
      const int row = brow + ai * HALF + wr * 64 + m * 16 + fr;
      if constexpr (MODE == G_Z0 || MODE == G_Z1 || MODE == G_MKV0 || MODE == G_MKV1) {
        const float rs = rs8[ai][m];
#pragma unroll
        for (int bj = 0; bj < 2; ++bj) {
          const f32x4 a0 = acc[ai][bj][m][0], a1 = acc[ai][bj][m][1];
          const unsigned x0 = cvtpk(a0[0] * rs, a0[1] * rs), x1 = cvtpk(a0[2] * rs, a0[3] * rs);
          const unsigned y0 = cvtpk(a1[0] * rs, a1[1] * rs), y1 = cvtpk(a1[2] * rs, a1[3] * rs);
          const auto s0 = __builtin_amdgcn_permlane16_swap(x0, y0, false, false), s1 = __builtin_amdgcn_permlane16_swap(x1, y1, false, false);
          const u32x4 w = {s0[0], s1[0], s0[1], s1[1]};
          const int col = bcol + bj * HALF + wc * 32 + (fq & 1) * 16 + (fq >> 1) * 8;
          if constexpr (MODE == G_Z0) {
            if (col < 704) *reinterpret_cast<u32x4*>((bf16*)(ws + OFF_ZA) + (size_t)row * 704 + col) = w;
            else if (col < 2752) *reinterpret_cast<u32x4*>((bf16*)p.out + (size_t)row * 2048 + (col - 704)) = w;
          } else if constexpr (MODE == G_Z1) {
            if (col < 1280) *reinterpret_cast<u32x4*>((bf16*)(ws + OFF_Z1A) + (size_t)row * 1280 + col) = w;
            else *reinterpret_cast<u32x4*>((bf16*)(ws + OFF_Z1B) + (size_t)row * 2048 + (col - 1280)) = w;
          } else {
            *reinterpret_cast<u32x4*>((bf16*)(ws + OFF_MEMKV + (MODE == G_MKV1 ? MEMKV_BYTES : 0)) + (size_t)row * 1024 + col) = w;
          }
        }
      } else {
        float* dst = p.out + (size_t)row * 1024;
        float ssl = 0.f;
#pragma unroll
        for (int bj = 0; bj < 2; ++bj)
#pragma unroll
          for (int n = 0; n < 2; ++n) {
            const int col = bcol + bj * HALF + wc * 32 + n * 16 + fq * 4;
            const f32x4 a = acc[ai][bj][m][n];
            f32x4 x = resv[m][bj * 2 + n];
            x[0] += a[0]; x[1] += a[1]; x[2] += a[2]; x[3] += a[3];
            *reinterpret_cast<f32x4*>(dst + col) = x;
            if constexpr (MODE == G_OUT0) {
              ssl += x[0] * x[0] + x[1] * x[1] + x[2] * x[2] + x[3] * x[3];
              *reinterpret_cast<u32x2*>((bf16*)(ws + OFF_X1B) + (size_t)row * 1024 + col) = u32x2{cvtpk(x[0], x[1]), cvtpk(x[2], x[3])};
            }
          }
        if constexpr (MODE == G_OUT0) {
          ssl += __shfl_xor(ssl, 16, 64); ssl += __shfl_xor(ssl, 32, 64);
          if (fq == 0) atomicAdd((float*)(ws + OFF_SS1) + row, ssl);
        }
      }
    }
  }
}

template <int MODE> DEVI void gemm_tiles_grouped(const Params& p, int t, int nM, int nN) {
  constexpr int WGM = 8;
  const int nig = WGM * nN, gid = t / nig, fm = gid * WGM, gsz = min(nM - fm, WGM);
  const int pm = fm + ((t % nig) % gsz), pn = (t % nig) / gsz;
  gemm_tile<MODE>(p, pm, pn);
}

DEVI void phase_gemm1(const Params& p) {
  constexpr int NZ = 192 * 11, NT = NZ + 2 * 48;
  for (int it = 0;; ++it) {
    const int t = remap_tile(it); if (it * (int)gridDim.x >= NT) break; if (t >= NT) continue;
    if (t < NZ) gemm_tiles_grouped<G_Z0>(p, t, 192, 11);
    else { const int u = t - NZ; if (u < 48) gemm_tile<G_MKV0>(p, u % 12, u / 12); else gemm_tile<G_MKV1>(p, (u - 48) % 12, (u - 48) / 12); }
  }
}
template <int MODE> DEVI void phase_gemm_simple(const Params& p, int nN) {
  const int NT = 192 * nN;
  for (int it = 0;; ++it) {
    const int t = remap_tile(it); if (it * (int)gridDim.x >= NT) break; if (t >= NT) continue;
    gemm_tiles_grouped<MODE>(p, t, 192, nN);
  }
}

DEVI int swz128(int row, int ch) { return row * 128 + ((ch ^ ((row >> 1) & 7)) << 4); }

template <int KDIM, int NB>
DEVI void small_gemm(const bf16* __restrict__ A  , int lda, const bf16* __restrict__ W  ,
                     f32x16 (&acc)[NB], float& ssrow, int tid) {
  constexpr int NC = KDIM / 64, WPT = NB * 32 * 8 / 512;
  const int wid = tid >> 6, lane = tid & 63, r32 = lane & 31, hi = lane >> 5;
  char* lds = g_smem;
  int aoff[4], woff[WPT];
#pragma unroll
  for (int i_ = 0; i_ < 4; ++i_) { const int q_ = tid + 512 * i_, row_ = q_ >> 3, ch_ = (q_ & 7) ^ ((row_ >> 1) & 7); aoff[i_] = row_ * lda + ch_ * 8; }
#pragma unroll
  for (int i_ = 0; i_ < WPT; ++i_) { const int q_ = tid + 512 * i_, row_ = q_ >> 3, ch_ = (q_ & 7) ^ ((row_ >> 1) & 7); woff[i_] = row_ * KDIM + ch_ * 8; }
#define SG_LOAD(b, c) do { const bf16* ag_ = A + (c) * 64; const bf16* wg_ = W + (c) * 64;                                     \
    _Pragma("unroll") for (int i_ = 0; i_ < 4; ++i_)                                                                           \
      __builtin_amdgcn_global_load_lds((const unsigned*)(ag_ + aoff[i_]), (unsigned*)(lds + (b) * 32768 + (tid + 512 * i_) * 16), 16, 0, 0); \
    _Pragma("unroll") for (int i_ = 0; i_ < WPT; ++i_)                                                                         \
      __builtin_amdgcn_global_load_lds((const unsigned*)(wg_ + woff[i_]), (unsigned*)(lds + 65536 + (b) * 32768 + (tid + 512 * i_) * 16), 16, 0, 0); } while (0)
#pragma unroll
  for (int nb = 0; nb < NB; ++nb) acc[nb] = f32x16{};
  float ss = 0.f;
  __syncthreads();
  SG_LOAD(0, 0); asm volatile("s_waitcnt vmcnt(0)" ::: "memory"); __syncthreads();
#pragma unroll 1
  for (int c = 0; c < NC; ++c) {
    const int b = c & 1;
    if (c + 1 < NC) SG_LOAD(b ^ 1, c + 1);
#pragma unroll
    for (int ks = 0; ks < 4; ++ks) {
      const int ch = ks * 2 + hi;
      const bf16x8 a = *reinterpret_cast<const bf16x8*>(lds + b * 32768 + swz128(wid * 32 + r32, ch));
      const u32x4 au = __builtin_bit_cast(u32x4, a);
#pragma unroll
      for (int j = 0; j < 4; ++j) { const float lo = bflo(au[j]), h2 = bfhi(au[j]); ss += lo * lo + h2 * h2; }
#pragma unroll
      for (int nb = 0; nb < NB; ++nb) {
        const bf16x8 w = *reinterpret_cast<const bf16x8*>(lds + 65536 + b * 32768 + swz128(nb * 32 + r32, ch));
        acc[nb] = __builtin_amdgcn_mfma_f32_32x32x16_bf16(w, a, acc[nb], 0, 0, 0);
      }
      SBAR();
    }
    asm volatile("s_waitcnt vmcnt(0)" ::: "memory"); __syncthreads();
  }
  ssrow = swap_sum(ss);
#undef SG_LOAD
}

DEVI void rope_pair(f32x16& x1, f32x16& x2, const float* __restrict__ rc, const float* __restrict__ rs, int pos, int hi) {
#pragma unroll
  for (int g = 0; g < 4; ++g) {
    const f32x4 c = *reinterpret_cast<const f32x4*>(rc + pos * 32 + 8 * g + 4 * hi);
    const f32x4 s = *reinterpret_cast<const f32x4*>(rs + pos * 32 + 8 * g + 4 * hi);
#pragma unroll
    for (int j = 0; j < 4; ++j) { const float a = x1[4 * g + j], b = x2[4 * g + j]; x1[4 * g + j] = a * c[j] - b * s[j]; x2[4 * g + j] = b * c[j] + a * s[j]; }
  }
}
DEVI void store_blk(bf16* __restrict__ dst  , const f32x16& v, int hi) {
  bf16x8 o0, o1; PK4(v, 0, o0); PK4(v, 8, o1);
  *reinterpret_cast<bf16x8*>(dst + hi * 8) = o0; *reinterpret_cast<bf16x8*>(dst + 16 + hi * 8) = o1;
}

DEVI void scale_gain_blk(f32x16& v, const f32x16& a, float f, const float* __restrict__ gain  , int hi) {
#pragma unroll
  for (int g = 0; g < 4; ++g) {
    const f32x4 gn = *reinterpret_cast<const f32x4*>(gain + 8 * g + 4 * hi);
#pragma unroll
    for (int j = 0; j < 4; ++j) v[4 * g + j] = a[4 * g + j] * (f * gn[j]);
  }
}
DEVI void gain_inplace(f32x16& v, float f, const float* __restrict__ gain, int hi) {
  float gs[32];
  cfloat_p cg = (cfloat_p)(uintptr_t)gain;
#pragma unroll
  for (int i = 0; i < 32; ++i) gs[i] = cg[i];
#pragma unroll
  for (int g = 0; g < 4; ++g)
#pragma unroll
    for (int j = 0; j < 4; ++j) v[4 * g + j] *= f * (hi ? gs[8 * g + 4 + j] : gs[8 * g + j]);
}
DEVI void rope_cs(int pos, int i, float& c, float& s) {
  const float inv = __builtin_amdgcn_exp2f(-(float)i * (13.287712379549449f / 32.f)) * 0.15915494309189535f;
  float rev = (float)pos * inv; rev -= floorf(rev);
  c = __builtin_amdgcn_cosf(rev); s = __builtin_amdgcn_sinf(rev);
}
DEVI void rope_inplace(f32x16& x1, f32x16& x2, int pos, int hi) {
#pragma unroll
  for (int g = 0; g < 4; ++g)
#pragma unroll
    for (int j = 0; j < 4; ++j) { float c, s; rope_cs(pos, 8 * g + 4 * hi + j, c, s);
      const float a = x1[4 * g + j], b = x2[4 * g + j]; x1[4 * g + j] = a * c - b * s; x2[4 * g + j] = b * c + a * s; }
}
DEVI void p2_epi_q(const Params& p, f32x16 (&acc)[6], float rs, int tok, int h, int hi) {
  char* ws = p.ws; LAUNDER_PTR(ws);
  float hs = 0.f;
#pragma unroll
  for (int nb = 0; nb < 6; ++nb)
#pragma unroll
    for (int r = 0; r < 16; ++r) hs += acc[nb][r] * acc[nb][r];
  hs = swap_sum(hs) * rs * rs;
  const float f = rs * rsqrtf(hs * (1.f / 192.f) + EPS) * (0.07216878364870322f * LOG2E);
  const int pos = tok & (SEQ - 1);
  bf16* dst = (bf16*)(ws + OFF_Q0) + (size_t)tok * 1536 + h * 192;
  SBAR();
  gain_inplace(acc[4], f, p.a_q_norm + 128, hi); gain_inplace(acc[5], f, p.a_q_norm + 160, hi);
  rope_inplace(acc[4], acc[5], pos, hi);
  store_blk(dst + 128, acc[4], hi); SBAR(); store_blk(dst + 160, acc[5], hi); SBAR();
#pragma unroll
  for (int nb = 0; nb < 4; ++nb) { gain_inplace(acc[nb], f, p.a_q_norm + nb * 32, hi); store_blk(dst + nb * 32, acc[nb], hi); SBAR(); }
}
DEVI void p2_epi_k(const Params& p, f32x16 (&acc)[4], float rs, int tok, int h, int hi, const u32x2 (&kra)[4], const u32x2 (&krb)[4], float kq) {
  char* ws = p.ws; LAUNDER_PTR(ws);
  const int pos = tok & (SEQ - 1);
  float ks = 0.f;
#pragma unroll
  for (int nb = 0; nb < 4; ++nb)
#pragma unroll
    for (int r = 0; r < 16; ++r) ks += acc[nb][r] * acc[nb][r];
  ks = swap_sum(ks * rs * rs + kq);
  const float rk = rsqrtf(ks * (1.f / 192.f) + EPS);
  bf16* kd = (bf16*)(ws + OFF_K0) + (size_t)tok * 1536 + h * 192;
  SBAR();
  float g1s[32], g2s[32];
  { cfloat_p ck = (cfloat_p)(uintptr_t)p.a_k_norm;
#pragma unroll
    for (int i = 0; i < 32; ++i) { g1s[i] = ck[128 + i]; g2s[i] = ck[160 + i]; } }
#pragma unroll
  for (int hf = 0; hf < 2; ++hf) {
    float x1[8], x2[8];
#pragma unroll
    for (int gg = 0; gg < 2; ++gg) {
      const int g = 2 * hf + gg;
      const u32x2 a = kra[g], b = krb[g];
      const float av[4] = {bflo(a[0]), bfhi(a[0]), bflo(a[1]), bfhi(a[1])}, bv[4] = {bflo(b[0]), bfhi(b[0]), bflo(b[1]), bfhi(b[1])};
#pragma unroll
      for (int j = 0; j < 4; ++j) { float c, sn; rope_cs(pos, 8 * g + 4 * hi + j, c, sn);
        const float u = av[j] * rk * (hi ? g1s[8 * g + 4 + j] : g1s[8 * g + j]), w = bv[j] * rk * (hi ? g2s[8 * g + 4 + j] : g2s[8 * g + j]);
        x1[4 * gg + j] = u * c - w * sn; x2[4 * gg + j] = w * c + u * sn; }
    }
    bf16x8 o1, o2; PK4(x1, 0, o1); PK4(x2, 0, o2);
    *reinterpret_cast<bf16x8*>(kd + 128 + hf * 16 + hi * 8) = o1; *reinterpret_cast<bf16x8*>(kd + 160 + hf * 16 + hi * 8) = o2;
  }
#pragma unroll
  for (int nb = 0; nb < 4; ++nb) { gain_inplace(acc[nb], rs * rk, p.a_k_norm + nb * 32, hi); store_blk(kd + nb * 32, acc[nb], hi); SBAR(); }
}
DEVI void p2_epi_v(const Params& p, f32x16 (&acc)[4], float rs, int tok, int h, int hi) {
  char* ws = p.ws; LAUNDER_PTR(ws);
  bf16* vd = (bf16*)(ws + OFF_V0) + (size_t)tok * 1024 + h * 128;
#pragma unroll
  for (int nb = 0; nb < 4; ++nb) {
#pragma unroll
    for (int r = 0; r < 16; ++r) acc[nb][r] *= rs;
    store_blk(vd + nb * 32, acc[nb], hi); SBAR();
  }
}

template <bool ISQ>
DEVI void p2_job(const Params& p, int mt, int half) {
  constexpr int KDIM = ISQ ? 384 : 256, NFR = KDIM / 16, NB = ISQ ? 6 : 4, NC = KDIM / 64, NPART = ISQ ? 4 : 8;
  constexpr int ROWS = NB * 32, LPC = ROWS * 8 / 512, STG = ROWS * 128, NSTG = ISQ ? 4 : 5, DEPTH = NSTG - 1;
  constexpr int NFH = ISQ ? NFR - 4 : NFR;
  char* ws = p.ws; LAUNDER_PTR(ws); char* lds = g_smem;
  LAUNDER_TID(tid); const int wid = tid >> 6, lane = tid & 63, r32 = lane & 31, hi = lane >> 5;
  const int tok = mt * 256 + wid * 32 + r32;
  const bf16* Wb = ISQ ? (const bf16*)(ws + OFF_WQ) + (size_t)(half * 4) * 192 * 384 : (const bf16*)(ws + OFF_WKV) + (size_t)(half * 4) * 256 * 256;
  int ip = 0, ic = 0, si = 0;
#define P2_ISSUE() do { const bf16* wg_ = Wb + (size_t)ip * (ROWS * KDIM) + ic * 64; const unsigned woff0 = (tid >> 3) * KDIM + (((tid & 7) ^ ((tid >> 4) & 7)) * 8); \
    _Pragma("unroll") for (int i_ = 0; i_ < LPC; ++i_)                                                                          \
      __builtin_amdgcn_global_load_lds((const unsigned*)((wg_ + i_ * 64 * KDIM) + woff0), (unsigned*)(lds + si * STG + (tid + 512 * i_) * 16), 16, 0, 0); \
    si = (si == NSTG - 1) ? 0 : si + 1;                                                                                         \
    if (!(ip == NPART - 1 && ic == NC - 1)) { if (++ic == NC) { ic = 0; ++ip; } } } while (0)
  const bf16* arow = (const bf16*)(ws + OFF_ZA) + (size_t)tok * 704 + (ISQ ? 0 : 384) + hi * 8;
  float ss = 0.f;
#pragma unroll
  for (int f = 0; f < NFR; ++f) { const u32x4 au = *reinterpret_cast<const u32x4*>(arow + f * 16);
#pragma unroll
    for (int j = 0; j < 4; ++j) { const float lo = bflo(au[j]), h2 = bfhi(au[j]); ss += lo * lo + h2 * h2; } }
  const float rs = rsqrtf(swap_sum(ss) * (1.f / KDIM) + EPS);
  asm volatile("" ::: "memory"); SBAR();
  __syncthreads();
  P2_ISSUE(); P2_ISSUE(); P2_ISSUE(); if constexpr (DEPTH == 4) P2_ISSUE();
  SBAR();
  bf16x8 af[NFH];
#pragma unroll
  for (int f = 0; f < NFH; ++f) af[f] = *reinterpret_cast<const bf16x8*>(arow + f * 16);
  char* apark = lds + NSTG * STG + wid * 4096 + lane * 16;
  if constexpr (ISQ) {
#pragma unroll
    for (int f = 0; f < 4; ++f) { const bf16x8 t = *reinterpret_cast<const bf16x8*>(arow + (NFH + f) * 16); *reinterpret_cast<bf16x8*>(apark + f * 1024) = t; }
  }
  asm volatile("s_waitcnt vmcnt(0)" ::: "memory");
  u32x2 kra[4] = {}, krb[4] = {}; float kq = 0.f;
  if constexpr (!ISQ) {
    const bf16* kr = (const bf16*)(ws + OFF_ZA) + (size_t)tok * 704 + 640;
#pragma unroll
    for (int g = 0; g < 4; ++g) { kra[g] = *reinterpret_cast<const u32x2*>(kr + 8 * g + 4 * hi); krb[g] = *reinterpret_cast<const u32x2*>(kr + 32 + 8 * g + 4 * hi); }
#pragma unroll
    for (int g = 0; g < 4; ++g) {
      kq += bflo(kra[g][0]) * bflo(kra[g][0]) + bfhi(kra[g][0]) * bfhi(kra[g][0]) + bflo(kra[g][1]) * bflo(kra[g][1]) + bfhi(kra[g][1]) * bfhi(kra[g][1]);
      kq += bflo(krb[g][0]) * bflo(krb[g][0]) + bfhi(krb[g][0]) * bfhi(krb[g][0]) + bflo(krb[g][1]) * bflo(krb[g][1]) + bfhi(krb[g][1]) * bfhi(krb[g][1]);
    }
  }
  int sc = 0;
#define P2_PART() do {                                                                                                           \
    _Pragma("unroll") for (int nb = 0; nb < NB; ++nb) acc[nb] = f32x16{};                                                       \
    _Pragma("unroll") for (int c = 0; c < NC; ++c) {                                                                            \
      if (c >= DEPTH) asm volatile("s_waitcnt vmcnt(%0)" :: "n"((DEPTH - 1) * LPC) : "memory");                                  \
      __builtin_amdgcn_s_barrier();                                                                                              \
      P2_ISSUE();                                                                                                                \
      const char* wl = lds + sc * STG;                                                                                           \
      _Pragma("unroll") for (int ks = 0; ks < 4; ++ks) {                                                                        \
        const int ch = ks * 2 + hi; bf16x8 afl = {};                                                                             \
        if (c * 4 + ks >= NFH) afl = *reinterpret_cast<const bf16x8*>(apark + (c * 4 + ks - NFH) * 1024);                        \
        _Pragma("unroll") for (int nb = 0; nb < NB; ++nb) {                                                                     \
          const bf16x8 w = *reinterpret_cast<const bf16x8*>(wl + swz128(nb * 32 + r32, ch));                                     \
          acc[nb] = __builtin_amdgcn_mfma_f32_32x32x16_bf16(w, (c * 4 + ks < NFH) ? af[(c * 4 + ks < NFH) ? c * 4 + ks : 0] : afl, acc[nb], 0, 0, 0); \
          if (NB == 6 && nb == 2) SBAR();                                                                                        \
        }                                                                                                                        \
        SBAR();                                                                                                                  \
      }                                                                                                                          \
      sc = (sc == NSTG - 1) ? 0 : sc + 1;                                                                                        \
    } } while (0)
#pragma unroll 1
  for (int pi = 0; pi < NPART; ++pi) {
    f32x16 acc[NB];
    P2_PART();
    asm volatile("s_waitcnt vmcnt(0)" ::: "memory");
    { LAUNDER_TID(t2); const int tok2 = mt * 256 + (t2 >> 6) * 32 + (t2 & 31), hi2 = (t2 >> 5) & 1;
      if constexpr (ISQ) p2_epi_q(p, acc, rs, tok2, half * 4 + pi, hi2);
      else { if (pi & 1) p2_epi_v(p, acc, rs, tok2, half * 4 + (pi >> 1), hi2); else p2_epi_k(p, acc, rs, tok2, half * 4 + (pi >> 1), hi2, kra, krb, kq); } }
  }
  asm volatile("s_waitcnt vmcnt(0)" ::: "memory");
#undef P2_PART
#undef P2_ISSUE
}

DEVI void phase_p2(const Params& p) {
  constexpr int NJ = 768;
  for (int it = 0;; ++it) {
    const int t = remap_tile(it); if (it * (int)gridDim.x >= NJ) break; if (t >= NJ) continue;
    const int mt = t >> 2, sub = t & 3;
    if (sub < 2) p2_job<true>(p, mt, sub); else p2_job<false>(p, mt, sub - 2);
  }
  char* ws = p.ws; LAUNDER_TID(tid);
  const int wid = tid >> 6, lane = tid & 63, nw = gridDim.x * 8;
  for (int r = blockIdx.x * 8 + wid; r < 2 * NMEMROW; r += nw) {
    const int l = r / NMEMROW, row = r % NMEMROW;
    bf16* kp = (bf16*)(ws + OFF_MEMKV + (size_t)l * MEMKV_BYTES) + (size_t)row * 1024;
    const float* gn = p.mem_k_norm + l * 128;
    {
      const int col = lane * 8;
      const u32x4 w = *reinterpret_cast<const u32x4*>(kp + col);
      float v[8]; float ss = 0.f;
#pragma unroll
      for (int j = 0; j < 4; ++j) { v[2 * j] = bflo(w[j]); v[2 * j + 1] = bfhi(w[j]); ss += v[2 * j] * v[2 * j] + v[2 * j + 1] * v[2 * j + 1]; }
      ss += __shfl_xor(ss, 1, 64); ss += __shfl_xor(ss, 2, 64); ss += __shfl_xor(ss, 4, 64); ss += __shfl_xor(ss, 8, 64);
      const float rr = rsqrtf(ss * (1.f / 128.f) + EPS);
      const int d = col & 127;
#pragma unroll
      for (int j = 0; j < 8; ++j) v[j] *= rr * gn[d + j];
      *reinterpret_cast<u32x4*>(kp + col) = u32x4{cvtpk(v[0], v[1]), cvtpk(v[2], v[3]), cvtpk(v[4], v[5]), cvtpk(v[6], v[7])};
    }
  }
}

constexpr int KVBLK = 64;
constexpr float THR = 8.f;
template <int DQK> DEVI int kswz(int row, int colB) {
  if constexpr (DQK == 128) return row * 256 + (colB ^ ((row & 7) << 4));
  else return row * 384 + (colB ^ (((row >> 1) & 7) << 4));
}
DEVI int v_st(int k, int c) { const int kk = (k & ~0xC) | ((k & 4) << 1) | ((k & 8) >> 1); return ((kk >> 3) * 4 + (c >> 5)) * 512 + ((kk & 7) * 32 + (c & 31)) * 2; }
DEVI int v_rd_base(int lane) { return ((lane & 3) << 3) | (((lane >> 2) & 3) << 6) | (((lane >> 4) & 1) << 5) | (((lane >> 5) & 1) << 8); }
constexpr int v_rd_off(int d0, int ks, int half) { return d0 * 512 + ks * 4096 + half * 2048; }
template <int OFF> DEVI s16x4 tr_read(int vb) { s16x4 r; asm volatile("ds_read_b64_tr_b16 %0, %1 offset:%2" : "=&v"(r) : "v"(vb), "i"(OFF) : "memory"); return r; }
template <int D0> DEVI void pv_one(f32x16& od, int vb, bf16x8 pa0, bf16x8 pa1, bf16x8 pa2, bf16x8 pa3) {
  const s16x4 l0 = tr_read<v_rd_off(D0, 0, 0)>(vb), h0 = tr_read<v_rd_off(D0, 0, 1)>(vb), l1 = tr_read<v_rd_off(D0, 1, 0)>(vb), h1 = tr_read<v_rd_off(D0, 1, 1)>(vb);
  const s16x4 l2 = tr_read<v_rd_off(D0, 2, 0)>(vb), h2 = tr_read<v_rd_off(D0, 2, 1)>(vb), l3 = tr_read<v_rd_off(D0, 3, 0)>(vb), h3 = tr_read<v_rd_off(D0, 3, 1)>(vb);
  asm volatile("s_waitcnt lgkmcnt(0)" ::: "memory"); SBAR();
#define PKV(L, H) (bf16x8){L[0], L[1], L[2], L[3], H[0], H[1], H[2], H[3]}
  od = __builtin_amdgcn_mfma_f32_32x32x16_bf16(pa0, PKV(l0, h0), od, 0, 0, 0);
  od = __builtin_amdgcn_mfma_f32_32x32x16_bf16(pa1, PKV(l1, h1), od, 0, 0, 0);
  od = __builtin_amdgcn_mfma_f32_32x32x16_bf16(pa2, PKV(l2, h2), od, 0, 0, 0);
  od = __builtin_amdgcn_mfma_f32_32x32x16_bf16(pa3, PKV(l3, h3), od, 0, 0, 0);
#undef PKV
}
DEVI void pv_d0(f32x16* o, int vb, bf16x8 pa0, bf16x8 pa1, bf16x8 pa2, bf16x8 pa3) {
  pv_one<0>(o[0], vb, pa0, pa1, pa2, pa3); pv_one<1>(o[1], vb, pa0, pa1, pa2, pa3); pv_one<2>(o[2], vb, pa0, pa1, pa2, pa3); pv_one<3>(o[3], vb, pa0, pa1, pa2, pa3);
}
template <int DQK> DEVI void partialSM(f32x16& p0, f32x16& p1, float& m_reg, float& mn, float& alpha) {
  constexpr float SCALE = (DQK == 192) ? 0.07216878364870322f : 0.08838834764831845f;
  constexpr float C = SCALE * LOG2E;
  float pmax = p0[0];
#pragma unroll
  for (int r = 1; r < 16; ++r) pmax = fmaxf(pmax, p0[r]);
#pragma unroll
  for (int r = 0; r < 16; ++r) pmax = fmaxf(pmax, p1[r]);
  pmax = swap_max(pmax);
  if (__builtin_expect(__all(pmax - m_reg <= THR / SCALE), 1)) { mn = m_reg; alpha = 1.f; }
  else { mn = fmaxf(m_reg, pmax); alpha = __builtin_amdgcn_exp2f((m_reg - mn) * C); m_reg = mn; }
  const float mnC = -mn * C;
#pragma unroll
  for (int r = 0; r < 16; ++r) p0[r] = fmaf(p0[r], C, mnC);
#pragma unroll
  for (int r = 0; r < 16; ++r) p1[r] = fmaf(p1[r], C, mnC);
#pragma unroll
  for (int r = 0; r < 16; ++r) p0[r] = __builtin_amdgcn_exp2f(p0[r]);
}
DEVI void finishSM(f32x16& p0, f32x16& p1, float alpha, float& l_reg, bf16x8& pa0, bf16x8& pa1, bf16x8& pa2, bf16x8& pa3) {
#pragma unroll
  for (int r = 0; r < 16; ++r) p1[r] = __builtin_amdgcn_exp2f(p1[r]);
  float ps = 0;
#pragma unroll
  for (int r = 0; r < 16; ++r) ps += p0[r];
#pragma unroll
  for (int r = 0; r < 16; ++r) ps += p1[r];
  ps = swap_sum(ps);
  l_reg = l_reg * alpha + ps;
  PK4(p0, 0, pa0); PK4(p0, 8, pa1); PK4(p1, 0, pa2); PK4(p1, 8, pa3);
}
template <int DQK> DEVI void qkt_acc(f32x16& p0, f32x16& p1, const char* Ks, const bf16x8* qr, int r32, int hi) {
#pragma unroll
  for (int d0 = 0; d0 < DQK / 16; ++d0) { const int cb = (d0 * 16 + hi * 8) * 2;
    const bf16x8 b0 = *reinterpret_cast<const bf16x8*>(Ks + kswz<DQK>(r32, cb));
    const bf16x8 b1 = *reinterpret_cast<const bf16x8*>(Ks + kswz<DQK>(32 + r32, cb));
    p0 = __builtin_amdgcn_mfma_f32_32x32x16_bf16(b0, qr[d0], p0, 0, 0, 0);
    p1 = __builtin_amdgcn_mfma_f32_32x32x16_bf16(b1, qr[d0], p1, 0, 0, 0); }
}
DEVI float silu_f(float g) { return g * __builtin_amdgcn_rcpf(1.f + __builtin_amdgcn_exp2f(-g * LOG2E)); }

template <int DQK, bool QNORM>
DEVI void attn_dense(const bf16* __restrict__ Qb, int ldq, const bf16* __restrict__ Kh, int ldk, const bf16* __restrict__ Vh, int ldv,
                     const bf16* __restrict__ Gb, int ldg, bf16* __restrict__ Ob, int ldo, int seq, const float* __restrict__ qgain, float negM) {
  constexpr int ND0 = DQK / 16, NCH = DQK / 8, KPT = NCH / 8;
  constexpr int SHM_V = 16384, SHM_K = 64 * DQK * 2;
  char* lds = g_smem;
  LAUNDER_TID(tid); const int wid = tid >> 6, lane = tid & 63, r32 = lane & 31, hi = lane >> 5;
  char* V_lds = lds; char* K_lds = lds + 2 * SHM_V;
  float* wsf = (float*)(lds + 2 * SHM_V + 2 * SHM_K) + wid * 64; float* li_l = wsf; float* al_l = wsf + 32;
  float l_reg = 0; f32x16 o[4] = {}; bf16x8 qr[ND0];
  const bf16* Qw = Qb + (size_t)(wid * 32 + r32) * ldq + hi * 8;
#pragma unroll
  for (int d0 = 0; d0 < ND0; ++d0) qr[d0] = *reinterpret_cast<const bf16x8*>(Qw + d0 * 16);
  if constexpr (QNORM) {
    float ss = 0.f;
#pragma unroll
    for (int d0 = 0; d0 < ND0; ++d0) { const u32x4 u = __builtin_bit_cast(u32x4, qr[d0]);
#pragma unroll
      for (int j = 0; j < 4; ++j) { const float a = bflo(u[j]), b = bfhi(u[j]); ss += a * a + b * b; } }
    ss = swap_sum(ss);
    const float rq = rsqrtf(ss * (1.f / DQK) + EPS) * (0.08838834764831845f * LOG2E);
#pragma unroll
    for (int d0 = 0; d0 < ND0; ++d0) { const u32x4 u = __builtin_bit_cast(u32x4, qr[d0]); u32x4 w;
      const f32x4 g0 = *reinterpret_cast<const f32x4*>(qgain + d0 * 16 + hi * 8), g1 = *reinterpret_cast<const f32x4*>(qgain + d0 * 16 + hi * 8 + 4);
      w[0] = cvtpk(bflo(u[0]) * rq * g0[0], bfhi(u[0]) * rq * g0[1]); w[1] = cvtpk(bflo(u[1]) * rq * g0[2], bfhi(u[1]) * rq * g0[3]);
      w[2] = cvtpk(bflo(u[2]) * rq * g1[0], bfhi(u[2]) * rq * g1[1]); w[3] = cvtpk(bflo(u[3]) * rq * g1[2], bfhi(u[3]) * rq * g1[3]);
      qr[d0] = __builtin_bit_cast(bf16x8, w); }
  }
  int kgo[KPT], vgo[2];
#pragma unroll
  for (int i = 0; i < KPT; ++i) { const int q = tid + 512 * i, row = q / NCH, chp = q % NCH;
    const int ch = (DQK == 128) ? (chp ^ (row & 7)) : (chp ^ ((row >> 1) & 7)); kgo[i] = row * ldk + ch * 8; }
#pragma unroll
  for (int i = 0; i < 2; ++i) { const int q = tid + 512 * i, st = q >> 5, kk = (st >> 2) * 8 + ((q >> 2) & 7), cc = q & 3;
    const int k = (kk & ~0xC) | ((kk & 4) << 1) | ((kk & 8) >> 1); vgo[i] = k * ldv + (st & 3) * 32 + cc * 8; }
  const int vb0 = (int)(uintptr_t)V_lds + v_rd_base(lane);
#define GLOAD(b, k0) do { const bf16* kg_ = Kh + (size_t)(k0) * ldk; const bf16* vg_ = Vh + (size_t)(k0) * ldv;               \
    _Pragma("unroll") for (int q_ = 0; q_ < KPT; ++q_) __builtin_amdgcn_global_load_lds((const unsigned*)(kg_ + kgo[q_]), (unsigned*)(K_lds + (b) * SHM_K + q_ * 8192 + tid * 16), 16, 0, 0); \
    _Pragma("unroll") for (int q_ = 0; q_ < 2; ++q_) __builtin_amdgcn_global_load_lds((const unsigned*)(vg_ + vgo[q_]), (unsigned*)(V_lds + (b) * SHM_V + q_ * 8192 + tid * 16), 16, 0, 0); } while (0)
  const int NT = seq / KVBLK;
  __syncthreads();
  GLOAD(0, 0);
  asm volatile("s_waitcnt vmcnt(0)" ::: "memory"); __syncthreads();
  for (int j = 0; j < NT; ++j) {
    const int b = j & 1;
    if (j + 1 < NT) GLOAD(b ^ 1, (j + 1) * KVBLK);
    f32x16 p0, p1; bf16x8 pa0, pa1, pa2, pa3;
#pragma unroll
    for (int r = 0; r < 16; ++r) { p0[r] = negM; p1[r] = negM; }
    qkt_acc<DQK>(p0, p1, K_lds + b * SHM_K, qr, r32, hi);
#pragma unroll
    for (int r = 0; r < 16; ++r) { p0[r] = __builtin_amdgcn_exp2f(p0[r]); p1[r] = __builtin_amdgcn_exp2f(p1[r]); }
    float ps = 0.f;
#pragma unroll
    for (int r = 0; r < 16; ++r) ps += p0[r] + p1[r];
    l_reg += ps;
    PK4(p0, 0, pa0); PK4(p0, 8, pa1); PK4(p1, 0, pa2); PK4(p1, 8, pa3);
    pv_d0(o, vb0 + b * SHM_V, pa0, pa1, pa2, pa3);
    asm volatile("s_waitcnt vmcnt(0)" ::: "memory"); __syncthreads();
  }
  l_reg = swap_sum(l_reg);
  if (hi == 0) li_l[r32] = l_reg; asm volatile("s_waitcnt lgkmcnt(0)" ::: "memory");
  const bf16* Gw = Gb + (size_t)(wid * 32) * ldg; bf16* Ow = Ob + (size_t)(wid * 32) * ldo;
#pragma unroll
  for (int r = 0; r < 16; ++r) { const int orow = crow(r, hi); const float rl = __builtin_amdgcn_rcpf(li_l[orow]);
#pragma unroll
    for (int d0 = 0; d0 < 4; ++d0) {
      const float g = __bfloat162float(Gw[(size_t)orow * ldg + d0 * 32 + r32]);
      Ow[(size_t)orow * ldo + d0 * 32 + r32] = __float2bfloat16(o[d0][r] * rl * silu_f(g));
    } }
#undef GLOAD
}

DEVI void mla_item(const Params& p, int t, float negM) {
  char* ws = p.ws; const int qb = t & 15, h = (t >> 4) & 7, b = t >> 7;
  const size_t tok0 = (size_t)b * SEQ + qb * 256, tokb = (size_t)b * SEQ;
  bf16* Q = (bf16*)(ws + OFF_Q0) + tok0 * 1536 + h * 192;
  attn_dense<192, false>(Q, 1536, (const bf16*)(ws + OFF_K0) + tokb * 1536 + h * 192, 1536, (const bf16*)(ws + OFF_V0) + tokb * 1024 + h * 128, 1024,
                         (const bf16*)p.out + tok0 * 2048 + 512 + h * 128, 2048, Q, 1536, SEQ, nullptr, negM);
}
template <int L> DEVI void mem_item(const Params& p, int t, float negM) {
  char* ws = p.ws; const int qb = t & 15, hm = (t >> 4) & 3, b = t >> 6;
  const size_t tok0 = (size_t)b * SEQ + qb * 256;
  const bf16* zb = (L == 0 ? (const bf16*)p.out : (const bf16*)(ws + OFF_Z1B)) + tok0 * 2048;
  const bf16* kv = (const bf16*)(ws + OFF_MEMKV + (size_t)L * MEMKV_BYTES) + (size_t)b * 256 * 1024 + hm * 128;
  bf16* mo = (bf16*)(ws + (L == 0 ? OFF_MEMO0 : OFF_MEMO1)) + tok0 * 512 + hm * 128;
  attn_dense<128, true>(zb + hm * 128, 2048, kv, 1024, kv + 512, 1024, zb + 512 + 1024 + hm * 128, 2048, mo, 512, 256, p.mem_q_norm + L * 128, negM);
}
DEVI float softmax_shift(const float* __restrict__ gq, const float* __restrict__ gk, int n) {
  float mq = 0.f, mk = 0.f;
  cfloat_p cq = (cfloat_p)(uintptr_t)gq, ck = (cfloat_p)(uintptr_t)gk;
  for (int i = 0; i < n; ++i) { mq = fmaxf(mq, fabsf(cq[i])); mk = fmaxf(mk, fabsf(ck[i])); }
  return -LOG2E * sqrtf((float)n) * mq * mk;
}
DEVI void phase_attn0(const Params& p) {
  const float negM_mla = softmax_shift(p.a_q_norm, p.a_k_norm, 192), negM_mem = softmax_shift(p.mem_q_norm, p.mem_k_norm, 128);
  constexpr int NJ = 1536 + 768;
  for (int it = 0;; ++it) {
    const int t = remap_tile(it); if (it * (int)gridDim.x >= NJ) break; if (t >= NJ) continue;
    if (t < 1536) mla_item(p, t, negM_mla); else mem_item<0>(p, t - 1536, negM_mem);
  }
}

DEVI void phase_knorm(const Params& p) {
  char* ws = p.ws; const bf16* z = (const bf16*)(ws + OFF_Z1A); bf16* kn = (bf16*)(ws + OFF_KN);
  LAUNDER_TID(tid);
  const long gt = (long)blockIdx.x * 512 + tid, gsz = (long)gridDim.x * 512;
  for (long i = gt; i < (long)NTOK * 16; i += gsz) {
    const long tok = i >> 4; const int c = (int)(i & 15) * 8;
    const u32x4 w = *reinterpret_cast<const u32x4*>(z + tok * 1280 + 1024 + c);
    float v[8]; float ss = 0.f;
#pragma unroll
    for (int j = 0; j < 4; ++j) { v[2 * j] = bflo(w[j]); v[2 * j + 1] = bfhi(w[j]); ss += v[2 * j] * v[2 * j] + v[2 * j + 1] * v[2 * j + 1]; }
    ss += __shfl_xor(ss, 1, 64); ss += __shfl_xor(ss, 2, 64); ss += __shfl_xor(ss, 4, 64);
    const float rr = rsqrtf(ss * (1.f / 64.f) + EPS);
    const int d = c & 63;
#pragma unroll
    for (int j = 0; j < 8; ++j) v[j] *= rr * p.b_k_norm[d + j];
    *reinterpret_cast<u32x4*>(kn + tok * 128 + c) = u32x4{cvtpk(v[0], v[1]), cvtpk(v[2], v[3]), cvtpk(v[4], v[5]), cvtpk(v[6], v[7])};
  }
}

constexpr int v_rd_off64(int d0, int ks, int half) { return ((2 * ks + half) * 2 + d0) * 512; }
template <int KS> DEVI void pv_ks64(f32x16* o, int vb, bf16x8 pa) {
  const s16x4 l0 = tr_read<v_rd_off64(0, KS, 0)>(vb), h0 = tr_read<v_rd_off64(0, KS, 1)>(vb), l1 = tr_read<v_rd_off64(1, KS, 0)>(vb), h1 = tr_read<v_rd_off64(1, KS, 1)>(vb);
  asm volatile("s_waitcnt lgkmcnt(0)" ::: "memory"); SBAR();
#define PKV(L, H) (bf16x8){L[0], L[1], L[2], L[3], H[0], H[1], H[2], H[3]}
  o[0] = __builtin_amdgcn_mfma_f32_32x32x16_bf16(pa, PKV(l0, h0), o[0], 0, 0, 0);
  o[1] = __builtin_amdgcn_mfma_f32_32x32x16_bf16(pa, PKV(l1, h1), o[1], 0, 0, 0);
#undef PKV
}
DEVI void swa_item(const Params& p, int t, float bound2) {
  char* ws = p.ws; LAUNDER_PTR(ws); char* lds = g_smem;
  const int qc = t & 127, kvh = (t >> 7) & 1, b = t >> 8;
  LAUNDER_TID(tid); const int wid = tid >> 6, lane = tid & 63, r32 = lane & 31, hi = lane >> 5;
  const int hq = kvh * 8 + wid, i0 = qc * 32; const size_t tokb = (size_t)b * SEQ;
  bf16* z1a = (bf16*)(ws + OFF_Z1A); const bf16* kn = (const bf16*)(ws + OFF_KN); const bf16* z1b = (const bf16*)(ws + OFF_Z1B);
  char* K_lds = lds; char* V_lds = lds + 5 * 8192; float* li_l = (float*)(lds + 10 * 8192) + wid * 64;
  const int ts0 = (i0 - 128) & ~63;
  const int jlo = ts0 < 0 ? (-ts0) >> 6 : 0, jhi = min(5, (SEQ - ts0) >> 6);
  __syncthreads();
  {
    const int krow = tid >> 3, kch = (tid & 7) ^ ((krow >> 1) & 7);
    const int st = tid >> 5, kk = (st >> 1) * 8 + ((tid >> 2) & 7), vk = (kk & ~0xC) | ((kk & 4) << 1) | ((kk & 8) >> 1), vcol = (st & 1) * 32 + (tid & 3) * 8;
    const bf16* kg = kn + (tokb + ts0 + krow) * 128 + kvh * 64 + kch * 8;
    const bf16* vg = z1a + (tokb + ts0 + vk) * 1280 + 1152 + kvh * 64 + vcol;
    for (int j = jlo; j < jhi; ++j) {
      __builtin_amdgcn_global_load_lds((const unsigned*)(kg + (size_t)j * 64 * 128), (unsigned*)(K_lds + j * 8192 + tid * 16), 16, 0, 0);
      __builtin_amdgcn_global_load_lds((const unsigned*)(vg + (size_t)j * 64 * 1280), (unsigned*)(V_lds + j * 8192 + tid * 16), 16, 0, 0);
    }
  }
  const bf16* Gw = z1b + (tokb + i0) * 2048 + 512 + hq * 64 + r32;
  unsigned gpk[16];
#pragma unroll
  for (int r = 0; r < 16; ++r) { const int orow = crow(r, hi);
    const unsigned g0 = *reinterpret_cast<const unsigned short*>(Gw + (size_t)orow * 2048), g1 = *reinterpret_cast<const unsigned short*>(Gw + (size_t)orow * 2048 + 32);
    gpk[r] = g0 | (g1 << 16); }
  bf16* Qw = z1a + (tokb + i0 + r32) * 1280 + hq * 64;
  bf16x8 qr[4];
  { float ss = 0.f; u32x4 u[4];
#pragma unroll
    for (int d0 = 0; d0 < 4; ++d0) { u[d0] = *reinterpret_cast<const u32x4*>(Qw + d0 * 16 + hi * 8);
#pragma unroll
      for (int j = 0; j < 4; ++j) { const float a = bflo(u[d0][j]), c = bfhi(u[d0][j]); ss += a * a + c * c; } }
    ss = swap_sum(ss);
    const float rq = rsqrtf(ss * (1.f / 64.f) + EPS) * (0.125f * LOG2E);
#pragma unroll
    for (int d0 = 0; d0 < 4; ++d0) { u32x4 w;
      const f32x4 g0 = *reinterpret_cast<const f32x4*>(p.b_q_norm + d0 * 16 + hi * 8), g1 = *reinterpret_cast<const f32x4*>(p.b_q_norm + d0 * 16 + hi * 8 + 4);
      w[0] = cvtpk(bflo(u[d0][0]) * rq * g0[0], bfhi(u[d0][0]) * rq * g0[1]); w[1] = cvtpk(bflo(u[d0][1]) * rq * g0[2], bfhi(u[d0][1]) * rq * g0[3]);
      w[2] = cvtpk(bflo(u[d0][2]) * rq * g1[0], bfhi(u[d0][2]) * rq * g1[1]); w[3] = cvtpk(bflo(u[d0][3]) * rq * g1[2], bfhi(u[d0][3]) * rq * g1[3]);
      qr[d0] = __builtin_bit_cast(bf16x8, w); }
  }
  const float slope2 = exp2f(-0.5f * (float)(hq + 1)) * LOG2E, sink2 = p.b_sink[hq] * LOG2E;
  const float negM = -fmaxf(bound2, sink2);
  float l_reg = 0.f;
  f32x16 o[2] = {};
  const int vb0 = (int)(uintptr_t)V_lds + v_rd_base(lane);
  const int query = i0 + r32;
  asm volatile("s_waitcnt vmcnt(0)" ::: "memory"); __syncthreads();
  for (int j = jlo; j < jhi; ++j) {
    const int ts = ts0 + 64 * j; const char* Kt = K_lds + j * 8192;
    f32x16 p0, p1;
#pragma unroll
    for (int r = 0; r < 16; ++r) { p0[r] = negM; p1[r] = negM; }
#pragma unroll
    for (int d0 = 0; d0 < 4; ++d0) { const int ch = d0 * 2 + hi;
      const bf16x8 b0 = *reinterpret_cast<const bf16x8*>(Kt + swz128(r32, ch));
      const bf16x8 b1 = *reinterpret_cast<const bf16x8*>(Kt + swz128(32 + r32, ch));
      p0 = __builtin_amdgcn_mfma_f32_32x32x16_bf16(b0, qr[d0], p0, 0, 0, 0);
      p1 = __builtin_amdgcn_mfma_f32_32x32x16_bf16(b1, qr[d0], p1, 0, 0, 0); }
    const float fb0 = (float)(ts - query + 4 * hi), fb1 = fb0 + 32.f;
    const bool full = (ts - (i0 + 31) >= -128) && (ts + 63 - i0 <= 128);
    float ps = 0.f;
    if (full) {
#pragma unroll
      for (int r = 0; r < 16; ++r) { const float off = (float)((r & 3) + 8 * (r >> 2));
        p0[r] = __builtin_amdgcn_exp2f(fmaf(-slope2, fabsf(fb0 + off), p0[r]));
        p1[r] = __builtin_amdgcn_exp2f(fmaf(-slope2, fabsf(fb1 + off), p1[r]));
        ps += p0[r] + p1[r]; }
    } else {
#pragma unroll
      for (int r = 0; r < 16; ++r) { const float off = (float)((r & 3) + 8 * (r >> 2));
        const float e0 = fabsf(fb0 + off), e1 = fabsf(fb1 + off);
        p0[r] = e0 <= 128.f ? __builtin_amdgcn_exp2f(fmaf(-slope2, e0, p0[r])) : 0.f;
        p1[r] = e1 <= 128.f ? __builtin_amdgcn_exp2f(fmaf(-slope2, e1, p1[r])) : 0.f;
        ps += p0[r] + p1[r]; }
    }
    l_reg += ps;
    const int vb = vb0 + j * 8192; bf16x8 pa;
    PK4(p0, 0, pa); pv_ks64<0>(o, vb, pa); PK4(p0, 8, pa); pv_ks64<1>(o, vb, pa);
    PK4(p1, 0, pa); pv_ks64<2>(o, vb, pa); PK4(p1, 8, pa); pv_ks64<3>(o, vb, pa);
  }
  l_reg = swap_sum(l_reg) + __builtin_amdgcn_exp2f(sink2 + negM);
  if (hi == 0) li_l[r32] = l_reg; asm volatile("s_waitcnt lgkmcnt(0)" ::: "memory");
  bf16* Ow = z1a + (tokb + i0) * 1280 + hq * 64 + r32;
#pragma unroll
  for (int r = 0; r < 16; ++r) { const int orow = crow(r, hi); const float rl = __builtin_amdgcn_rcpf(li_l[orow]);
    Ow[(size_t)orow * 1280] = __float2bfloat16(o[0][r] * rl * silu_f(bflo(gpk[r])));
    Ow[(size_t)orow * 1280 + 32] = __float2bfloat16(o[1][r] * rl * silu_f(bfhi(gpk[r])));
  }
}
DEVI void phase_attn1(const Params& p) {
  const float negM_mem = softmax_shift(p.mem_q_norm + 128, p.mem_k_norm + 128, 128), bound2_swa = -softmax_shift(p.b_q_norm, p.b_k_norm, 64);
  constexpr int NJ = 3072 + 768;
  for (int it = 0;; ++it) {
    const int t = remap_tile(it); if (it * (int)gridDim.x >= NJ) break; if (t >= NJ) continue;
    if (t < 768) mem_item<1>(p, t, negM_mem); else swa_item(p, t - 768, bound2_swa);
  }
}

#define XB_TMO      128
#define XB_XCNT(j)  (256  + 64 * (j))
#define XB_XSUB(j)  (1280 + 64 * (j))
#define XB_XGEN(j)  (2304 + 64 * (j))
#define XB_TOP      3328
#define XB_TOPGEN   3392
#define XB_SPIN_CAP (1u << 20)
#define LAS __attribute__((address_space(3)))
DEVI unsigned xb_ld(unsigned* p)              { return __hip_atomic_load(p, __ATOMIC_RELAXED, __HIP_MEMORY_SCOPE_AGENT); }
DEVI unsigned xb_add(unsigned* p, unsigned v) { return __hip_atomic_fetch_add(p, v, __ATOMIC_RELAXED, __HIP_MEMORY_SCOPE_AGENT); }
DEVI unsigned xb_xcc_id() { return (unsigned)__builtin_amdgcn_s_getreg((3 << 11) | 20) & 0xFu; }
#define XB_SPIN(cond, bar) do { unsigned _sp = 0; while (cond) { __builtin_amdgcn_s_sleep(1); \
    if ((++_sp & 255u) == 0u) { if (xb_ld(&(bar)[XB_TMO])) break; if (_sp > XB_SPIN_CAP) { atomicAdd(&(bar)[XB_TMO], 1u); break; } } } } while (0)
struct XcdBarrier { unsigned* bar; unsigned x; volatile LAS unsigned* st; };
DEVI XcdBarrier xcd_barrier_post(unsigned* bar, volatile LAS unsigned* st) {
  XcdBarrier b; b.bar = bar; b.x = xb_xcc_id(); b.st = st;
  if (threadIdx.x == 0) (void)xb_add(&bar[XB_XCNT(b.x)], 1u);
  return b;
}
DEVI void xcd_barrier_complete(unsigned* bar, unsigned x, unsigned& nloc, unsigned& nx) {
  const unsigned G = gridDim.x * gridDim.y * gridDim.z;
  unsigned sum, cnt, mine, sp = 0u;
  for (;;) {
    sum = 0u; cnt = 0u; mine = 0u;
#pragma unroll
    for (unsigned j = 0; j < 16; ++j) { const unsigned c = xb_ld(&bar[XB_XCNT(j)]); sum += c; cnt += (c > 0u) ? 1u : 0u; mine = (j == x) ? c : mine; }
    if (sum == G) break;
    __builtin_amdgcn_s_sleep(1);
    if ((++sp & 255u) == 0u) { if (xb_ld(&bar[XB_TMO])) break; if (sp > XB_SPIN_CAP) { atomicAdd(&bar[XB_TMO], 1u); break; } }
  }
  nloc = mine > 0u ? mine : 1u; nx = cnt > 0u ? cnt : 1u;
}
DEVI void xcd_barrier(const XcdBarrier& b) {
  asm volatile("s_waitcnt vmcnt(0)" ::: "memory");
  __syncthreads();
  if (threadIdx.x == 0) {
    unsigned* bar = b.bar;
    __builtin_amdgcn_s_waitcnt(0);
    unsigned nloc = b.st[0], nx = b.st[1];
    if (nloc == 0u) { xcd_barrier_complete(bar, b.x, nloc, nx); b.st[0] = nloc; b.st[1] = nx; }
    const unsigned old = xb_add(&bar[XB_XSUB(b.x)], 1u);
    const unsigned gen = old / nloc;
    if (old + 1u == (gen + 1u) * nloc) {
      __builtin_amdgcn_fence(__ATOMIC_RELEASE, "agent");
      asm volatile("s_waitcnt vmcnt(0)" ::: "memory");
      const unsigned og = xb_add(&bar[XB_TOP], 1u);
      const unsigned tg = og / nx;
      if (og + 1u == (tg + 1u) * nx) xb_add(&bar[XB_TOPGEN], 1u);
      else XB_SPIN(xb_ld(&bar[XB_TOPGEN]) == tg, bar);
      __builtin_amdgcn_fence(__ATOMIC_ACQUIRE, "agent");
      xb_add(&bar[XB_XGEN(b.x)], 1u);
      asm volatile("s_waitcnt vmcnt(0)" ::: "memory");
    } else {
      XB_SPIN(xb_ld(&bar[XB_XGEN(b.x)]) == gen, bar);
      __builtin_amdgcn_fence(__ATOMIC_ACQUIRE, "agent");
      asm volatile("s_waitcnt vmcnt(0)" ::: "memory");
    }
  }
  __syncthreads();
}
template <int PH> DEVI void run_phase(const Params& p) {
  if constexpr (PH == 0) phase_prep(p);
  else if constexpr (PH == 1) phase_gemm1(p);
  else if constexpr (PH == 2) phase_p2(p);
  else if constexpr (PH == 3) phase_attn0(p);
  else if constexpr (PH == 4) phase_gemm_simple<G_OUT0>(p, 4);
  else if constexpr (PH == 5) phase_gemm_simple<G_Z1>(p, 13);
  else if constexpr (PH == 6) phase_knorm(p);
  else if constexpr (PH == 7) phase_attn1(p);
  else phase_gemm_simple<G_OUT1>(p, 4);
}
#if MK_COOP
__global__ __launch_bounds__(512) void mega_coop(Params p) {
  cg::grid_group grid = cg::this_grid();
  __shared__ uint4 xb_words;
  if (threadIdx.x == 0) xb_words = uint4{0u, 0u, 0u, 0u};
  __syncthreads();
  const XcdBarrier xb = xcd_barrier_post((unsigned*)(p.ws + OFF_BAR), (volatile LAS unsigned*)&xb_words);
  if (p.ws == nullptr) grid.sync();
  phase_prep(p); xcd_barrier(xb);
  phase_gemm1(p); xcd_barrier(xb);
  phase_p2(p); xcd_barrier(xb);
  phase_attn0(p); xcd_barrier(xb);
  phase_gemm_simple<G_OUT0>(p, 4); xcd_barrier(xb);
  phase_gemm_simple<G_Z1>(p, 13); xcd_barrier(xb);
  phase_knorm(p); xcd_barrier(xb);
  phase_attn1(p); xcd_barrier(xb);
  phase_gemm_simple<G_OUT1>(p, 4);
}
#endif
template <int PH> __global__ __launch_bounds__(512) void mega_phase(Params p) { run_phase<PH>(p); }

extern "C" void kernel_launch(void* const* d_in, const int* in_sizes, int n_in, void* d_out, int out_size, void* d_ws, size_t ws_size, hipStream_t stream) {
  static int grid = 0;
  if (grid == 0) {
    if (n_in != 21 || out_size != NTOK * 1024 || ws_size < WS_NEED) { fprintf(stderr, "kernel_launch: unexpected shapes n_in %d out %d ws %zu\n", n_in, out_size, ws_size); grid = -1; return; }
    int dev = 0, cus = 0, per_cu = 0;
    (void)hipGetDevice(&dev); (void)hipDeviceGetAttribute(&cus, hipDeviceAttributeMultiprocessorCount, dev);
#if MK_COOP
    (void)hipFuncSetAttribute((const void*)mega_coop, hipFuncAttributeMaxDynamicSharedMemorySize, LDS_BYTES);
    (void)hipOccupancyMaxActiveBlocksPerMultiprocessor(&per_cu, (const void*)mega_coop, 512, LDS_BYTES);
#else
#define SETATTR(PH) (void)hipFuncSetAttribute((const void*)mega_phase<PH>, hipFuncAttributeMaxDynamicSharedMemorySize, LDS_BYTES)
    SETATTR(0); SETATTR(1); SETATTR(2); SETATTR(3); SETATTR(4); SETATTR(5); SETATTR(6); SETATTR(7); SETATTR(8);
    per_cu = 1;
#endif
    if (per_cu < 1) { fprintf(stderr, "kernel_launch: occupancy query says %d blocks/CU\n", per_cu); per_cu = 1; }
    grid = cus * 1;
  }
  if (grid < 0) return;
  { static const int exp_sz[21] = {8*4096*1024, 4*4096*1024, 8*256*1024, 4*256*1024, 2*1024, 2*1536*1024, 2*1024, 2*1024*1024, 2*128, 2*128,
      1024*2752, 384, 384*1536, 256, 256*2048, 192, 192, 1024*3328, 64, 64, 16};
    for (int i = 0; i < 21; ++i) if (in_sizes[i] != exp_sz[i]) { fprintf(stderr, "in_sizes[%d] = %d != %d\n", i, in_sizes[i], exp_sz[i]);
      return; } }
  Params p{};
  const float** pp = (const float**)&p;
  for (int i = 0; i < 21; ++i) pp[i] = (const float*)d_in[i];
  p.out = (float*)d_out; p.ws = (char*)d_ws;
#if MK_COOP
  (void)hipMemsetAsync((char*)d_ws + OFF_BAR, 0, 16384, stream);
  void* args[] = {&p};
  hipError_t e = hipLaunchCooperativeKernel((const void*)mega_coop, dim3(grid), dim3(512), args, LDS_BYTES, stream);
  if (e != hipSuccess) fprintf(stderr, "cooperative launch failed: %s (grid %d)\n", hipGetErrorString(e), grid);
#else
#define LAUNCH(PH) hipLaunchKernelGGL(mega_phase<PH>, dim3(grid), dim3(512), LDS_BYTES, stream, p)
  LAUNCH(0); LAUNCH(1); LAUNCH(2); LAUNCH(3); LAUNCH(4); LAUNCH(5); LAUNCH(6); LAUNCH(7); LAUNCH(8);
#endif
}
```

```cpp
#include <hip/hip_runtime.h>
#include <hip/hip_bf16.h>
#include <hip/hip_cooperative_groups.h>
#include <cstdio>
#include <cstdint>
namespace cg = cooperative_groups;

#ifndef MK_COOP
#define MK_COOP 1
#endif

using bf16   = __hip_bfloat16;
using bf16x8 = __attribute__((ext_vector_type(8))) short;
using s16x4  = __attribute__((ext_vector_type(4))) short;
using f32x16 = __attribute__((ext_vector_type(16))) float;
using f32x4  = __attribute__((ext_vector_type(4))) float;
using u32x4  = __attribute__((ext_vector_type(4))) unsigned;
using u32x2  = __attribute__((ext_vector_type(2))) unsigned;
using bf2_t  = __attribute__((ext_vector_type(2))) __bf16;
#define DEVI __device__ __forceinline__
typedef const __attribute__((address_space(4))) float* cfloat_p;
#define SBAR() __builtin_amdgcn_sched_barrier(0)
#define LAUNDER_TID(tid) int tid = threadIdx.x; asm volatile("" : "+v"(tid))
#define LAUNDER_PTR(ptr) asm volatile("" : "+s"(ptr))

constexpr int NTOK = 49152, SEQ = 4096, NPROMPT_TOK = 32768;
constexpr int NMEMROW = 3072, NPROMPT_MEM = 2048;
constexpr float EPS = 1e-6f;
constexpr float LOG2E = 1.4426950408889634f;

constexpr size_t MiB = 1ull << 20;
constexpr size_t WA_BYTES = 2816ull * 1024 * 2, WB_BYTES = 3328ull * 1024 * 2, WO_BYTES = 1024ull * 1536 * 2, WM_BYTES = 1024ull * 1024 * 2;
constexpr size_t WQ_BYTES = 1536ull * 384 * 2, WKV_BYTES = 2048ull * 256 * 2, MEMKV_BYTES = 3072ull * 1024 * 2;
constexpr size_t OFF_WA = 0;
constexpr size_t OFF_WB = OFF_WA + WA_BYTES;
constexpr size_t OFF_WO = OFF_WB + WB_BYTES;
constexpr size_t OFF_WM = OFF_WO + 2 * WO_BYTES;
constexpr size_t OFF_WQ = OFF_WM + 2 * WM_BYTES;
constexpr size_t OFF_WKV = OFF_WQ + WQ_BYTES;
constexpr size_t OFF_MEMKV = OFF_WKV + WKV_BYTES;
constexpr size_t OFF_MEMB = OFF_MEMKV + 2 * MEMKV_BYTES;
constexpr size_t OFF_SS0 = OFF_MEMB + 3072ull * 1024 * 2;
constexpr size_t OFF_SS1 = OFF_SS0 + NTOK * 4ull;
constexpr size_t OFF_SSM = OFF_SS1 + NTOK * 4ull;
constexpr size_t OFF_ROPE = OFF_SSM + NMEMROW * 4ull;
constexpr size_t OFF_W_END = OFF_ROPE + 2ull * 4096 * 32 * 4;
constexpr size_t OFF_BAR = 60 * MiB - 16384;
static_assert(OFF_W_END <= OFF_BAR, "weight region overflow");
constexpr size_t OFF_XB = 60 * MiB, OFF_Q0 = 60 * MiB, OFF_K0 = 204 * MiB, OFF_V0 = 348 * MiB, OFF_ZA = 446 * MiB, OFF_MEMO0 = 446 * MiB;
constexpr size_t OFF_X1B = 204 * MiB, OFF_Z1A = 60 * MiB, OFF_KN = 180 * MiB, OFF_MEMO1 = 204 * MiB, OFF_Z1B = 300 * MiB;
constexpr size_t WS_NEED = 512 * MiB;

struct Params {
  const float *x_prompt, *x_sample, *mem_prompt, *mem_sample, *norm_in, *w_out, *mem_norm, *w_mem_kv, *mem_q_norm, *mem_k_norm;
  const float *a_w_in, *a_q_a_norm, *a_w_q_b, *a_kv_a_norm, *a_w_kv_b, *a_q_norm, *a_k_norm, *b_w_in, *b_q_norm, *b_k_norm, *b_sink;
  float* out; char* ws;
};

extern __shared__ __attribute__((aligned(16))) char g_smem[];
constexpr int LDS_BYTES = 131072;

DEVI int crow(int r, int hi) { return (r & 3) + 8 * (r >> 2) + 4 * hi; }
DEVI unsigned cvtpk(float lo, float hi) { unsigned r; asm volatile("v_cvt_pk_bf16_f32 %0, %1, %2" : "=v"(r) : "v"(lo), "v"(hi)); return r; }
DEVI float bflo(unsigned w) { return __uint_as_float(w << 16); }
DEVI float bfhi(unsigned w) { return __uint_as_float(w & 0xffff0000u); }
DEVI float swap_sum(float v) { auto rr = __builtin_amdgcn_permlane32_swap(__float_as_uint(v), __float_as_uint(v), false, false); return __uint_as_float(rr[0]) + __uint_as_float(rr[1]); }
DEVI float swap_max(float v) { auto rr = __builtin_amdgcn_permlane32_swap(__float_as_uint(v), __float_as_uint(v), false, false); return fmaxf(__uint_as_float(rr[0]), __uint_as_float(rr[1])); }
#define PK4(P, BASE, OUT) do { unsigned a0_ = cvtpk(P[BASE + 0], P[BASE + 1]), a1_ = cvtpk(P[BASE + 2], P[BASE + 3]);   \
    unsigned b0_ = cvtpk(P[BASE + 4], P[BASE + 5]), b1_ = cvtpk(P[BASE + 6], P[BASE + 7]);                              \
    auto r0_ = __builtin_amdgcn_permlane32_swap(a0_, b0_, false, false); auto r1_ = __builtin_amdgcn_permlane32_swap(a1_, b1_, false, false); \
    u32x4 w_ = {r0_[0], r1_[0], r0_[1], r1_[1]}; OUT = __builtin_bit_cast(bf16x8, w_); } while (0)
DEVI const float* x_row(const Params& p, int tok) { return tok < NPROMPT_TOK ? p.x_prompt + (size_t)tok * 1024 : p.x_sample + (size_t)(tok - NPROMPT_TOK) * 1024; }
DEVI const float* mem_row(const Params& p, int r) { return r < NPROMPT_MEM ? p.mem_prompt + (size_t)r * 1024 : p.mem_sample + (size_t)(r - NPROMPT_MEM) * 1024; }
DEVI int remap_tile(int it) {
  const int G = gridDim.x, b = blockIdx.x;
  return (G & 7) ? it * G + b : it * G + (b & 7) * (G >> 3) + (b >> 3);
}

DEVI void wt_job(const float* __restrict__ W, const float* __restrict__ g, bf16* __restrict__ out, int K, int N, int Npad, long gt, long gsz) {
  const int nq = Npad >> 2; const long total = (long)nq * (K >> 3);
  for (long i = gt; i < total; i += gsz) {
    const int n4 = (int)(i % nq) << 2; const int k0 = (int)(i / nq) << 3;
    f32x4 v[8];
    if (n4 < N) {
#pragma unroll
      for (int j = 0; j < 8; ++j) { v[j] = *reinterpret_cast<const f32x4*>(W + (size_t)(k0 + j) * N + n4); const float gj = g ? g[k0 + j] : 1.f; v[j][0] *= gj; v[j][1] *= gj; v[j][2] *= gj; v[j][3] *= gj; }
    } else {
#pragma unroll
      for (int j = 0; j < 8; ++j) v[j] = f32x4{0.f, 0.f, 0.f, 0.f};
    }
#pragma unroll
    for (int c = 0; c < 4; ++c)
      *reinterpret_cast<u32x4*>(out + (size_t)(n4 + c) * K + k0) = u32x4{cvtpk(v[0][c], v[1][c]), cvtpk(v[2][c], v[3][c]), cvtpk(v[4][c], v[5][c]), cvtpk(v[6][c], v[7][c])};
  }
}
DEVI void row_job4(const Params& p, int r0, int lane) {
  char* ws = p.ws;
  f32x4 v[4][4];
#pragma unroll
  for (int k = 0; k < 4; ++k) { const int r = r0 + k;
    const float* src = r < NTOK ? x_row(p, r) : mem_row(p, r - NTOK);
#pragma unroll
    for (int i = 0; i < 2; ++i) { v[k][2 * i] = *reinterpret_cast<const f32x4*>(src + lane * 8 + 512 * i); v[k][2 * i + 1] = *reinterpret_cast<const f32x4*>(src + lane * 8 + 512 * i + 4); } }
#pragma unroll
  for (int k = 0; k < 4; ++k) { const int r = r0 + k;
    bf16* dst = r < NTOK ? (bf16*)(ws + OFF_XB) + (size_t)r * 1024 : (bf16*)(ws + OFF_MEMB) + (size_t)(r - NTOK) * 1024;
    float ss = 0.f;
#pragma unroll
    for (int i = 0; i < 2; ++i) { const f32x4 a = v[k][2 * i], c = v[k][2 * i + 1];
      ss += a[0] * a[0] + a[1] * a[1] + a[2] * a[2] + a[3] * a[3] + c[0] * c[0] + c[1] * c[1] + c[2] * c[2] + c[3] * c[3];
      *reinterpret_cast<u32x4*>(dst + lane * 8 + 512 * i) = u32x4{cvtpk(a[0], a[1]), cvtpk(a[2], a[3]), cvtpk(c[0], c[1]), cvtpk(c[2], c[3])}; }
#pragma unroll
    for (int o = 32; o > 0; o >>= 1) ss += __shfl_xor(ss, o, 64);
    if (lane == 0) { if (r < NTOK) ((float*)(ws + OFF_SS0))[r] = ss; else ((float*)(ws + OFF_SSM))[r - NTOK] = ss; }
  }
}
DEVI void phase_prep(const Params& p) {
  char* ws = p.ws; LAUNDER_TID(tid);
  const long gt = (long)blockIdx.x * 512 + tid, gsz = (long)gridDim.x * 512;
  wt_job(p.a_w_in, p.norm_in, (bf16*)(ws + OFF_WA), 1024, 2752, 2816, gt, gsz);
  wt_job(p.b_w_in, p.norm_in + 1024, (bf16*)(ws + OFF_WB), 1024, 3328, 3328, gt, gsz);
  wt_job(p.w_out, nullptr, (bf16*)(ws + OFF_WO), 1536, 1024, 1024, gt, gsz);
  wt_job(p.w_out + 1536 * 1024, nullptr, (bf16*)(ws + OFF_WO + WO_BYTES), 1536, 1024, 1024, gt, gsz);
  wt_job(p.w_mem_kv, p.mem_norm, (bf16*)(ws + OFF_WM), 1024, 1024, 1024, gt, gsz);
  wt_job(p.w_mem_kv + 1024 * 1024, p.mem_norm + 1024, (bf16*)(ws + OFF_WM + WM_BYTES), 1024, 1024, 1024, gt, gsz);
  wt_job(p.a_w_q_b, p.a_q_a_norm, (bf16*)(ws + OFF_WQ), 384, 1536, 1536, gt, gsz);
  wt_job(p.a_w_kv_b, p.a_kv_a_norm, (bf16*)(ws + OFF_WKV), 256, 2048, 2048, gt, gsz);
  float* rc = (float*)(ws + OFF_ROPE); float* rs = rc + 4096 * 32;
  for (long i = gt; i < 4096 * 32; i += gsz) {
    const int pos = (int)(i >> 5), f = (int)(i & 31);
    const float inv = exp2f(-(float)f * (13.287712379549449f / 32.f));
    float rev = (float)pos * inv * 0.15915494309189535f; rev -= floorf(rev);
    rc[i] = __builtin_amdgcn_cosf(rev); rs[i] = __builtin_amdgcn_sinf(rev);
  }
  float* ss1 = (float*)(ws + OFF_SS1);
  for (long i = gt; i < NTOK; i += gsz) ss1[i] = 0.f;
  const int wid = tid >> 6, lane = tid & 63;
  const int nw = gridDim.x * 8;
  for (int r = (blockIdx.x * 8 + wid) * 4; r < NTOK + NMEMROW; r += nw * 4) row_job4(p, r, lane);
}

enum { G_Z0 = 0, G_MKV0 = 1, G_MKV1 = 2, G_OUT0 = 3, G_Z1 = 4, G_OUT1 = 5 };
constexpr int BK = 64, HALF = 128, HT = HALF * BK;
DEVI int lds_byte(int r, int c) { int st = (r >> 4) * 2 + (c >> 5), rr = r & 15, cc = c & 31, ob = rr * 64 + cc * 2; return st * 1024 + (ob ^ (((ob >> 9) & 1) << 5)); }
DEVI void stage_rc(int b, int& R, int& C) { int st = b / 1024, sb = b % 1024, swz = sb ^ (((sb >> 9) & 1) << 5); R = (st >> 1) * 16 + swz / 64; C = (st & 1) * 32 + (swz % 64) / 2; }

template <int MODE> DEVI const bf16* a_ptr(const Params& p, int kt, int& lda) {
  char* ws = p.ws; const int k = kt * 64;
  if constexpr (MODE == G_Z0) { lda = 1024; return (const bf16*)(ws + OFF_XB) + k; }
  else if constexpr (MODE == G_MKV0 || MODE == G_MKV1) { lda = 1024; return (const bf16*)(ws + OFF_MEMB) + k; }
  else if constexpr (MODE == G_Z1) { lda = 1024; return (const bf16*)(ws + OFF_X1B) + k; }
  else if constexpr (MODE == G_OUT0) {
    if (k < 1024) { lda = 1536; return (const bf16*)(ws + OFF_Q0) + (k >> 7) * 192 + (k & 127); }
    lda = 512; return (const bf16*)(ws + OFF_MEMO0) + (k - 1024);
  } else {
    if (k < 1024) { lda = 1280; return (const bf16*)(ws + OFF_Z1A) + k; }
    lda = 512; return (const bf16*)(ws + OFF_MEMO1) + (k - 1024);
  }
}

template <int MODE>
DEVI void gemm_tile(const Params& p, int pm, int pn, bool pre = false, bool has_next = false, int pm2 = 0, int pn2 = 0) {
  constexpr int K = (MODE == G_OUT0 || MODE == G_OUT1) ? 1536 : 1024;
  constexpr int nt = K / BK;
  char* ws = p.ws; LAUNDER_TID(tid);
  const bf16* Bt = (const bf16*)(ws + (MODE == G_Z0 ? OFF_WA : MODE == G_MKV0 ? OFF_WM : MODE == G_MKV1 ? OFF_WM + WM_BYTES : MODE == G_OUT0 ? OFF_WO : MODE == G_Z1 ? OFF_WB : OFF_WO + WO_BYTES));
  bf16* shm = (bf16*)g_smem;
  const int brow = pm * 256, bcol = pn * 256, brow2 = pm2 * 256, bcol2 = pn2 * 256;
#define SA(b, h) (shm + ((b) * 2 + (h)) * HT)
#define SB(b, h) (shm + (4 + (b) * 2 + (h)) * HT)
#define STAGE_B(P, half, kt) do { const bf16* _g = Bt + (size_t)(bcol + (half) * HALF) * K + (size_t)(kt) * BK;              \
    _Pragma("unroll") for (int _i = 0; _i < 2; ++_i)                                                                          \
      __builtin_amdgcn_global_load_lds((const unsigned*)(_g + ((st_rc[_i] & 255) * K + (st_rc[_i] >> 8))), (unsigned*)((char*)(P) + tid * 16 + _i * 8192), 16, 0, 0); } while (0)
#define STAGE_A(P, half, kt) do { int _lda; const bf16* _g = a_ptr<MODE>(p, (kt), _lda) + (size_t)(brow + (half) * HALF) * _lda; \
    _Pragma("unroll") for (int _i = 0; _i < 2; ++_i)                                                                          \
      __builtin_amdgcn_global_load_lds((const unsigned*)(_g + ((st_rc[_i] & 255) * _lda + (st_rc[_i] >> 8))), (unsigned*)((char*)(P) + tid * 16 + _i * 8192), 16, 0, 0); } while (0)
#define STAGE_B2(P, half) do { const bf16* _g = Bt + (size_t)(bcol2 + (half) * HALF) * K;                                       \
    _Pragma("unroll") for (int _i = 0; _i < 2; ++_i)                                                                          \
      __builtin_amdgcn_global_load_lds((const unsigned*)(_g + ((st_rc[_i] & 255) * K + (st_rc[_i] >> 8))), (unsigned*)((char*)(P) + tid * 16 + _i * 8192), 16, 0, 0); } while (0)
#define STAGE_A2(P, half) do { int _lda; const bf16* _g = a_ptr<MODE>(p, 0, _lda) + (size_t)(brow2 + (half) * HALF) * _lda;       \
    _Pragma("unroll") for (int _i = 0; _i < 2; ++_i)                                                                          \
      __builtin_amdgcn_global_load_lds((const unsigned*)(_g + ((st_rc[_i] & 255) * _lda + (st_rc[_i] >> 8))), (unsigned*)((char*)(P) + tid * 16 + _i * 8192), 16, 0, 0); } while (0)
#define LDA(dst, b, h) for (int m = 0; m < 4; ++m) for (int k = 0; k < 2; ++k) \
    dst[m][k] = *reinterpret_cast<const bf16x8*>((char*)SA(b, h) + lds_byte(wr * 64 + m * 16 + fr, k * 32 + fq * 8))
#define LDB(dst, b, h) for (int n = 0; n < 2; ++n) for (int k = 0; k < 2; ++k) \
    dst[n][k] = *reinterpret_cast<const bf16x8*>((char*)SB(b, h) + lds_byte(wc * 32 + n * 16 + fr, k * 32 + fq * 8))
#define MMA(ai, bj, At_, Bt_) do { __builtin_amdgcn_s_setprio(1); \
    for (int m = 0; m < 4; ++m) for (int n = 0; n < 2; ++n) for (int k = 0; k < 2; ++k) \
      acc[ai][bj][m][n] = __builtin_amdgcn_mfma_f32_16x16x32_bf16(Bt_[n][k], At_[m][k], acc[ai][bj][m][n], 0, 0, 0); \
    __builtin_amdgcn_s_setprio(0); } while (0)
#define WAIT_V(n) asm volatile("s_waitcnt vmcnt(" #n ")" ::: "memory")
#define WAIT_L(n) asm volatile("s_waitcnt lgkmcnt(" #n ")" ::: "memory")
#define BAR __builtin_amdgcn_s_barrier()
  const int wid = tid >> 6, lane = tid & 63, wr = wid >> 2, wc = wid & 3, fr = lane & 15, fq = lane >> 4;
  f32x4 acc[2][2][4][2] = {};
  bf16x8 At[4][2], B0[2][2], B1[2][2];
  int st_rc[2];
#pragma unroll
  for (int i = 0; i < 2; ++i) { int r_, c_; stage_rc(tid * 16 + i * 8192, r_, c_); st_rc[i] = r_ | (c_ << 8); }
  if (pre) { BAR; }
  else { __syncthreads();
    STAGE_B(SB(0, 0), 0, 0); STAGE_A(SA(0, 0), 0, 0);
    STAGE_B(SB(0, 1), 1, 0); STAGE_A(SA(0, 1), 1, 0); }
  if (wr == 1) BAR;
  if (!pre) WAIT_V(4);
  BAR;
  STAGE_B(SB(1, 0), 0, 1); STAGE_A(SA(1, 0), 0, 1); STAGE_B(SB(1, 1), 1, 1);
  if (!pre) WAIT_V(6);
  BAR;
  for (int t = 0; t < nt - 2; t += 2) {
    LDB(B0, 0, 0); SBAR(); LDA(At, 0, 0); STAGE_A(SA(1, 1), 1, t + 1);
    WAIT_L(8); BAR; WAIT_L(0); MMA(0, 0, At, B0); BAR; SBAR();
    LDB(B1, 0, 1); STAGE_B(SB(0, 0), 0, t + 2);
    BAR; WAIT_L(0); MMA(0, 1, At, B1); BAR;
    LDA(At, 0, 1); STAGE_A(SA(0, 0), 0, t + 2);
    BAR; WAIT_L(0); MMA(1, 0, At, B0); BAR; SBAR();
    STAGE_B(SB(0, 1), 1, t + 2);
    WAIT_V(6); BAR; MMA(1, 1, At, B1); BAR;
    LDB(B0, 1, 0); SBAR(); LDA(At, 1, 0); STAGE_A(SA(0, 1), 1, t + 2);
    WAIT_L(8); BAR; WAIT_L(0); MMA(0, 0, At, B0); BAR; SBAR();
    LDB(B1, 1, 1); STAGE_B(SB(1, 0), 0, t + 3);
    BAR; WAIT_L(0); MMA(0, 1, At, B1); BAR;
    LDA(At, 1, 1); STAGE_A(SA(1, 0), 0, t + 3);
    BAR; WAIT_L(0); MMA(1, 0, At, B0); BAR; SBAR();
    STAGE_B(SB(1, 1), 1, t + 3);
    WAIT_V(6); BAR; MMA(1, 1, At, B1); BAR;
  }
  { LDB(B0, 0, 0); LDA(At, 0, 0); STAGE_A(SA(1, 1), 1, nt - 1);
    BAR; WAIT_L(0); MMA(0, 0, At, B0); BAR;
    LDB(B1, 0, 1); BAR; WAIT_L(0); MMA(0, 1, At, B1); BAR;
    LDA(At, 0, 1); WAIT_V(4); BAR; WAIT_L(0); MMA(1, 0, At, B0); MMA(1, 1, At, B1); BAR; }
  if (has_next) {
    STAGE_B2(SB(0, 0), 0); STAGE_A2(SA(0, 0), 0); STAGE_B2(SB(0, 1), 1); STAGE_A2(SA(0, 1), 1); }
  { LDB(B0, 1, 0); LDA(At, 1, 0); if (has_next) WAIT_V(10); else WAIT_V(2); BAR; WAIT_L(0); MMA(0, 0, At, B0); BAR;
    LDB(B1, 1, 1); if (has_next) WAIT_V(8); else WAIT_V(0); BAR; WAIT_L(0); MMA(0, 1, At, B1); BAR;
    LDA(At, 1, 1); BAR; WAIT_L(0); MMA(1, 0, At, B0); MMA(1, 1, At, B1); BAR; }
  if (wr == 0) BAR;
#undef SA
#undef SB
#undef STAGE_A
#undef STAGE_B
#undef STAGE_A2
#undef STAGE_B2
#undef LDA
#undef LDB
#undef MMA
  int brow_e = brow, bcol_e = bcol; asm volatile("" : "+s"(brow_e), "+s"(bcol_e));
  LAUNDER_TID(te); const int wr_e = te >> 8, wc_e = (te >> 6) & 3, fr_e = te & 15, fq_e = (te & 63) >> 4;
  float rs8[2][4];
  if constexpr (MODE == G_Z0 || MODE == G_Z1 || MODE == G_MKV0 || MODE == G_MKV1) {
    const float* ssp = (const float*)(ws + (MODE == G_Z0 ? OFF_SS0 : MODE == G_Z1 ? OFF_SS1 : OFF_SSM));
#pragma unroll
    for (int ai = 0; ai < 2; ++ai)
#pragma unroll
      for (int m = 0; m < 4; ++m) rs8[ai][m] = ssp[brow_e + ai * HALF + wr_e * 64 + m * 16 + fr_e];
    asm volatile("s_waitcnt vmcnt(0)" ::: "memory");
#pragma unroll
    for (int ai = 0; ai < 2; ++ai)
#pragma unroll
      for (int m = 0; m < 4; ++m) rs8[ai][m] = rsqrtf(rs8[ai][m] * (1.f / 1024.f) + EPS);
  }
#pragma unroll
  for (int ai = 0; ai < 2; ++ai) {
    f32x4 resv[4][4];
#pragma unroll
    for (int m = 0; m < 4; ++m) {
      const int row = brow_e + ai * HALF + wr_e * 64 + m * 16 + fr_e;
      if constexpr (MODE == G_OUT0 || MODE == G_OUT1) {
        if ((m & 1) == 0) {
#pragma unroll
          for (int mm = m; mm < m + 2; ++mm) { const int row2 = brow_e + ai * HALF + wr_e * 64 + mm * 16 + fr_e;
            const float* res = (MODE == G_OUT0) ? x_row(p, row2) : p.out + (size_t)row2 * 1024;
#pragma unroll
            for (int bj = 0; bj < 2; ++bj)
#pragma unroll
              for (int n = 0; n < 2; ++n) resv[mm][bj * 2 + n] = *reinterpret_cast<const f32x4*>(res + bcol_e + bj * HALF + wc_e * 32 + n * 16 + fq_e * 4); }
          asm volatile("s_waitcnt vmcnt(0)" ::: "memory");
        }
      }
      if constexpr (MODE == G_Z0 || MODE == G_Z1 || MODE == G_MKV0 || MODE == G_MKV1) {
        const float rs = rs8[ai][m];
#pragma unroll
        for (int bj = 0; bj < 2; ++bj) {
          const f32x4 a0 = acc[ai][bj][m][0], a1 = acc[ai][bj][m][1];
          const unsigned x0 = cvtpk(a0[0] * rs, a0[1] * rs), x1 = cvtpk(a0[2] * rs, a0[3] * rs);
          const unsigned y0 = cvtpk(a1[0] * rs, a1[1] * rs), y1 = cvtpk(a1[2] * rs, a1[3] * rs);
          const auto s0 = __builtin_amdgcn_permlane16_swap(x0, y0, false, false), s1 = __builtin_amdgcn_permlane16_swap(x1, y1, false, false);
          const u32x4 w = {s0[0], s1[0], s0[1], s1[1]};
          const int col = bcol_e + bj * HALF + wc_e * 32 + (fq_e & 1) * 16 + (fq_e >> 1) * 8;
          if constexpr (MODE == G_Z0) {
            if (col < 704) *reinterpret_cast<u32x4*>((bf16*)(ws + OFF_ZA) + (size_t)row * 704 + col) = w;
            else if (col < 2752) *reinterpret_cast<u32x4*>((bf16*)p.out + (size_t)row * 2048 + (col - 704)) = w;
          } else if constexpr (MODE == G_Z1) {
            if (col < 1280) *reinterpret_cast<u32x4*>((bf16*)(ws + OFF_Z1A) + (size_t)row * 1280 + col) = w;
            else *reinterpret_cast<u32x4*>((bf16*)(ws + OFF_Z1B) + (size_t)row * 2048 + (col - 1280)) = w;
          } else {
            *reinterpret_cast<u32x4*>((bf16*)(ws + OFF_MEMKV + (MODE == G_MKV1 ? MEMKV_BYTES : 0)) + (size_t)row * 1024 + col) = w;
          }
        }
      } else {
        float* dst = p.out + (size_t)row * 1024;
        float ssl = 0.f;
#pragma unroll
        for (int bj = 0; bj < 2; ++bj)
#pragma unroll
          for (int n = 0; n < 2; ++n) {
            const int col = bcol_e + bj * HALF + wc_e * 32 + n * 16 + fq_e * 4;
            const f32x4 a = acc[ai][bj][m][n];
            f32x4 x = resv[m][bj * 2 + n];
            x[0] += a[0]; x[1] += a[1]; x[2] += a[2]; x[3] += a[3];
            *reinterpret_cast<f32x4*>(dst + col) = x;
            if constexpr (MODE == G_OUT0) {
              ssl += x[0] * x[0] + x[1] * x[1] + x[2] * x[2] + x[3] * x[3];
              *reinterpret_cast<u32x2*>((bf16*)(ws + OFF_X1B) + (size_t)row * 1024 + col) = u32x2{cvtpk(x[0], x[1]), cvtpk(x[2], x[3])};
            }
          }
        if constexpr (MODE == G_OUT0) {
          ssl += __shfl_xor(ssl, 16, 64); ssl += __shfl_xor(ssl, 32, 64);
          if (fq_e == 0) atomicAdd((float*)(ws + OFF_SS1) + row, ssl);
        }
      }
    }
  }
}

DEVI void tile_coords(int t, int nM, int nN, int& pm, int& pn) {
  constexpr int WGM = 8;
  const int nig = WGM * nN, gid = t / nig, fm = gid * WGM, gsz = min(nM - fm, WGM);
  pm = fm + ((t % nig) % gsz); pn = (t % nig) / gsz;
}
DEVI void phase_gemm1(const Params& p) {
  constexpr int NZ = 192 * 11, NT = NZ + 2 * 48;
  bool pre = false;
  for (int it = 0;; ++it) {
    const int t = remap_tile(it); if (it * (int)gridDim.x >= NT) break; if (t >= NT) continue;
    if (t < NZ) {
      const int t2 = remap_tile(it + 1); const bool hn = ((it + 1) * (int)gridDim.x < NT) && (t2 < NZ);
      int pm, pn, pm2 = 0, pn2 = 0; tile_coords(t, 192, 11, pm, pn); if (hn) tile_coords(t2, 192, 11, pm2, pn2);
      gemm_tile<G_Z0>(p, pm, pn, pre, hn, pm2, pn2); pre = hn;
    } else { const int u = t - NZ; pre = false; if (u < 48) gemm_tile<G_MKV0>(p, u % 12, u / 12); else gemm_tile<G_MKV1>(p, (u - 48) % 12, (u - 48) / 12); }
  }
}
template <int MODE> DEVI void phase_gemm_simple(const Params& p, int nN) {
  const int NT = 192 * nN;
  bool pre = false;
  for (int it = 0;; ++it) {
    const int t = remap_tile(it); if (it * (int)gridDim.x >= NT) break; if (t >= NT) { pre = false; continue; }
    const int t2 = remap_tile(it + 1); const bool hn = ((it + 1) * (int)gridDim.x < NT) && (t2 < NT);
    int pm, pn, pm2 = 0, pn2 = 0; tile_coords(t, 192, nN, pm, pn); if (hn) tile_coords(t2, 192, nN, pm2, pn2);
    gemm_tile<MODE>(p, pm, pn, pre, hn, pm2, pn2); pre = hn;
  }
}

DEVI int swz128(int row, int ch) { return row * 128 + ((ch ^ ((row >> 1) & 7)) << 4); }

template <int KDIM, int NB>
DEVI void small_gemm(const bf16* __restrict__ A  , int lda, const bf16* __restrict__ W  ,
                     f32x16 (&acc)[NB], float& ssrow, int tid) {
  constexpr int NC = KDIM / 64, WPT = NB * 32 * 8 / 512;
  const int wid = tid >> 6, lane = tid & 63, r32 = lane & 31, hi = lane >> 5;
  char* lds = g_smem;
  int aoff[4], woff[WPT];
#pragma unroll
  for (int i_ = 0; i_ < 4; ++i_) { const int q_ = tid + 512 * i_, row_ = q_ >> 3, ch_ = (q_ & 7) ^ ((row_ >> 1) & 7); aoff[i_] = row_ * lda + ch_ * 8; }
#pragma unroll
  for (int i_ = 0; i_ < WPT; ++i_) { const int q_ = tid + 512 * i_, row_ = q_ >> 3, ch_ = (q_ & 7) ^ ((row_ >> 1) & 7); woff[i_] = row_ * KDIM + ch_ * 8; }
#define SG_LOAD(b, c) do { const bf16* ag_ = A + (c) * 64; const bf16* wg_ = W + (c) * 64;                                     \
    _Pragma("unroll") for (int i_ = 0; i_ < 4; ++i_)                                                                           \
      __builtin_amdgcn_global_load_lds((const unsigned*)(ag_ + aoff[i_]), (unsigned*)(lds + (b) * 32768 + (tid + 512 * i_) * 16), 16, 0, 0); \
    _Pragma("unroll") for (int i_ = 0; i_ < WPT; ++i_)                                                                         \
      __builtin_amdgcn_global_load_lds((const unsigned*)(wg_ + woff[i_]), (unsigned*)(lds + 65536 + (b) * 32768 + (tid + 512 * i_) * 16), 16, 0, 0); } while (0)
#pragma unroll
  for (int nb = 0; nb < NB; ++nb) acc[nb] = f32x16{};
  float ss = 0.f;
  __syncthreads();
  SG_LOAD(0, 0); asm volatile("s_waitcnt vmcnt(0)" ::: "memory"); __syncthreads();
#pragma unroll 1
  for (int c = 0; c < NC; ++c) {
    const int b = c & 1;
    if (c + 1 < NC) SG_LOAD(b ^ 1, c + 1);
#pragma unroll
    for (int ks = 0; ks < 4; ++ks) {
      const int ch = ks * 2 + hi;
      const bf16x8 a = *reinterpret_cast<const bf16x8*>(lds + b * 32768 + swz128(wid * 32 + r32, ch));
      const u32x4 au = __builtin_bit_cast(u32x4, a);
#pragma unroll
      for (int j = 0; j < 4; ++j) { const float lo = bflo(au[j]), h2 = bfhi(au[j]); ss += lo * lo + h2 * h2; }
#pragma unroll
      for (int nb = 0; nb < NB; ++nb) {
        const bf16x8 w = *reinterpret_cast<const bf16x8*>(lds + 65536 + b * 32768 + swz128(nb * 32 + r32, ch));
        acc[nb] = __builtin_amdgcn_mfma_f32_32x32x16_bf16(w, a, acc[nb], 0, 0, 0);
      }
      SBAR();
    }
    asm volatile("s_waitcnt vmcnt(0)" ::: "memory"); __syncthreads();
  }
  ssrow = swap_sum(ss);
#undef SG_LOAD
}

DEVI void rope_pair(f32x16& x1, f32x16& x2, const float* __restrict__ rc, const float* __restrict__ rs, int pos, int hi) {
#pragma unroll
  for (int g = 0; g < 4; ++g) {
    const f32x4 c = *reinterpret_cast<const f32x4*>(rc + pos * 32 + 8 * g + 4 * hi);
    const f32x4 s = *reinterpret_cast<const f32x4*>(rs + pos * 32 + 8 * g + 4 * hi);
#pragma unroll
    for (int j = 0; j < 4; ++j) { const float a = x1[4 * g + j], b = x2[4 * g + j]; x1[4 * g + j] = a * c[j] - b * s[j]; x2[4 * g + j] = b * c[j] + a * s[j]; }
  }
}
DEVI void store_blk(bf16* __restrict__ dst  , const f32x16& v, int hi) {
  bf16x8 o0, o1; PK4(v, 0, o0); PK4(v, 8, o1);
  *reinterpret_cast<bf16x8*>(dst + hi * 8) = o0; *reinterpret_cast<bf16x8*>(dst + 16 + hi * 8) = o1;
}

DEVI void scale_gain_blk(f32x16& v, const f32x16& a, float f, const float* __restrict__ gain  , int hi) {
#pragma unroll
  for (int g = 0; g < 4; ++g) {
    const f32x4 gn = *reinterpret_cast<const f32x4*>(gain + 8 * g + 4 * hi);
#pragma unroll
    for (int j = 0; j < 4; ++j) v[4 * g + j] = a[4 * g + j] * (f * gn[j]);
  }
}
DEVI void gain_inplace(f32x16& v, float f, const float* __restrict__ gain, int hi) {
  float gs[32];
  cfloat_p cg = (cfloat_p)(uintptr_t)gain;
#pragma unroll
  for (int i = 0; i < 32; ++i) gs[i] = cg[i];
#pragma unroll
  for (int g = 0; g < 4; ++g)
#pragma unroll
    for (int j = 0; j < 4; ++j) v[4 * g + j] *= f * (hi ? gs[8 * g + 4 + j] : gs[8 * g + j]);
}
DEVI void rope_cs(int pos, int i, float& c, float& s) {
  const float inv = __builtin_amdgcn_exp2f(-(float)i * (13.287712379549449f / 32.f)) * 0.15915494309189535f;
  float rev = (float)pos * inv; rev -= floorf(rev);
  c = __builtin_amdgcn_cosf(rev); s = __builtin_amdgcn_sinf(rev);
}
DEVI void rope_inplace(f32x16& x1, f32x16& x2, int pos, int hi) {
#pragma unroll
  for (int g = 0; g < 4; ++g)
#pragma unroll
    for (int j = 0; j < 4; ++j) { float c, s; rope_cs(pos, 8 * g + 4 * hi + j, c, s);
      const float a = x1[4 * g + j], b = x2[4 * g + j]; x1[4 * g + j] = a * c - b * s; x2[4 * g + j] = b * c + a * s; }
}
DEVI void p2_epi_q(const Params& p, f32x16 (&acc)[6], float rs, int tok, int h, int hi) {
  char* ws = p.ws; LAUNDER_PTR(ws);
  float hs = 0.f;
#pragma unroll
  for (int nb = 0; nb < 6; ++nb)
#pragma unroll
    for (int r = 0; r < 16; ++r) hs += acc[nb][r] * acc[nb][r];
  hs = swap_sum(hs) * rs * rs;
  const float f = rs * rsqrtf(hs * (1.f / 192.f) + EPS) * (0.07216878364870322f * LOG2E);
  const int pos = tok & (SEQ - 1);
  bf16* dst = (bf16*)(ws + OFF_Q0) + (size_t)tok * 1536 + h * 192;
  SBAR();
  gain_inplace(acc[4], f, p.a_q_norm + 128, hi); gain_inplace(acc[5], f, p.a_q_norm + 160, hi);
  rope_inplace(acc[4], acc[5], pos, hi);
  store_blk(dst + 128, acc[4], hi); SBAR(); store_blk(dst + 160, acc[5], hi); SBAR();
#pragma unroll
  for (int nb = 0; nb < 4; ++nb) { gain_inplace(acc[nb], f, p.a_q_norm + nb * 32, hi); store_blk(dst + nb * 32, acc[nb], hi); SBAR(); }
}
DEVI void p2_epi_k(const Params& p, f32x16 (&acc)[4], float rs, int tok, int h, int hi, const u32x2 (&kra)[4], const u32x2 (&krb)[4], float kq) {
  char* ws = p.ws; LAUNDER_PTR(ws);
  const int pos = tok & (SEQ - 1);
  float ks = 0.f;
#pragma unroll
  for (int nb = 0; nb < 4; ++nb)
#pragma unroll
    for (int r = 0; r < 16; ++r) ks += acc[nb][r] * acc[nb][r];
  ks = swap_sum(ks * rs * rs + kq);
  const float rk = rsqrtf(ks * (1.f / 192.f) + EPS);
  bf16* kd = (bf16*)(ws + OFF_K0) + (size_t)tok * 1536 + h * 192;
  SBAR();
  float g1s[32], g2s[32];
  { cfloat_p ck = (cfloat_p)(uintptr_t)p.a_k_norm;
#pragma unroll
    for (int i = 0; i < 32; ++i) { g1s[i] = ck[128 + i]; g2s[i] = ck[160 + i]; } }
#pragma unroll
  for (int hf = 0; hf < 2; ++hf) {
    float x1[8], x2[8];
#pragma unroll
    for (int gg = 0; gg < 2; ++gg) {
      const int g = 2 * hf + gg;
      const u32x2 a = kra[g], b = krb[g];
      const float av[4] = {bflo(a[0]), bfhi(a[0]), bflo(a[1]), bfhi(a[1])}, bv[4] = {bflo(b[0]), bfhi(b[0]), bflo(b[1]), bfhi(b[1])};
#pragma unroll
      for (int j = 0; j < 4; ++j) { float c, sn; rope_cs(pos, 8 * g + 4 * hi + j, c, sn);
        const float u = av[j] * rk * (hi ? g1s[8 * g + 4 + j] : g1s[8 * g + j]), w = bv[j] * rk * (hi ? g2s[8 * g + 4 + j] : g2s[8 * g + j]);
        x1[4 * gg + j] = u * c - w * sn; x2[4 * gg + j] = w * c + u * sn; }
    }
    bf16x8 o1, o2; PK4(x1, 0, o1); PK4(x2, 0, o2);
    *reinterpret_cast<bf16x8*>(kd + 128 + hf * 16 + hi * 8) = o1; *reinterpret_cast<bf16x8*>(kd + 160 + hf * 16 + hi * 8) = o2;
  }
#pragma unroll
  for (int nb = 0; nb < 4; ++nb) { gain_inplace(acc[nb], rs * rk, p.a_k_norm + nb * 32, hi); store_blk(kd + nb * 32, acc[nb], hi); SBAR(); }
}
DEVI void p2_epi_v(const Params& p, f32x16 (&acc)[4], float rs, int tok, int h, int hi) {
  char* ws = p.ws; LAUNDER_PTR(ws);
  bf16* vd = (bf16*)(ws + OFF_V0) + (size_t)tok * 1024 + h * 128;
#pragma unroll
  for (int nb = 0; nb < 4; ++nb) {
#pragma unroll
    for (int r = 0; r < 16; ++r) acc[nb][r] *= rs;
    store_blk(vd + nb * 32, acc[nb], hi); SBAR();
  }
}

template <bool ISQ>
DEVI void p2_job(const Params& p, int mt, int half) {
  constexpr int KDIM = ISQ ? 384 : 256, NFR = KDIM / 16, NB = ISQ ? 6 : 4, NC = KDIM / 64, NPART = ISQ ? 4 : 8;
  constexpr int ROWS = NB * 32, LPC = ROWS * 8 / 512, STG = ROWS * 128, NSTG = ISQ ? 4 : 5, DEPTH = NSTG - 1;
  constexpr int NFH = ISQ ? NFR - 4 : NFR;
  char* ws = p.ws; LAUNDER_PTR(ws); char* lds = g_smem;
  LAUNDER_TID(tid); const int wid = tid >> 6, lane = tid & 63, r32 = lane & 31, hi = lane >> 5;
  const int tok = mt * 256 + wid * 32 + r32;
  const bf16* Wb = ISQ ? (const bf16*)(ws + OFF_WQ) + (size_t)(half * 4) * 192 * 384 : (const bf16*)(ws + OFF_WKV) + (size_t)(half * 4) * 256 * 256;
  int ip = 0, ic = 0, si = 0;
#define P2_ISSUE() do { const bf16* wg_ = Wb + (size_t)ip * (ROWS * KDIM) + ic * 64; const unsigned woff0 = (tid >> 3) * KDIM + (((tid & 7) ^ ((tid >> 4) & 7)) * 8); \
    _Pragma("unroll") for (int i_ = 0; i_ < LPC; ++i_)                                                                          \
      __builtin_amdgcn_global_load_lds((const unsigned*)((wg_ + i_ * 64 * KDIM) + woff0), (unsigned*)(lds + si * STG + (tid + 512 * i_) * 16), 16, 0, 0); \
    si = (si == NSTG - 1) ? 0 : si + 1;                                                                                         \
    if (!(ip == NPART - 1 && ic == NC - 1)) { if (++ic == NC) { ic = 0; ++ip; } } } while (0)
  const bf16* arow = (const bf16*)(ws + OFF_ZA) + (size_t)tok * 704 + (ISQ ? 0 : 384) + hi * 8;
  float ss = 0.f;
#pragma unroll
  for (int f = 0; f < NFR; ++f) { const u32x4 au = *reinterpret_cast<const u32x4*>(arow + f * 16);
#pragma unroll
    for (int j = 0; j < 4; ++j) { const float lo = bflo(au[j]), h2 = bfhi(au[j]); ss += lo * lo + h2 * h2; } }
  const float rs = rsqrtf(swap_sum(ss) * (1.f / KDIM) + EPS);
  asm volatile("" ::: "memory"); SBAR();
  __syncthreads();
  P2_ISSUE(); P2_ISSUE(); P2_ISSUE(); if constexpr (DEPTH == 4) P2_ISSUE();
  SBAR();
  bf16x8 af[NFH];
#pragma unroll
  for (int f = 0; f < NFH; ++f) af[f] = *reinterpret_cast<const bf16x8*>(arow + f * 16);
  char* apark = lds + NSTG * STG + wid * 4096 + lane * 16;
  if constexpr (ISQ) {
#pragma unroll
    for (int f = 0; f < 4; ++f) { const bf16x8 t = *reinterpret_cast<const bf16x8*>(arow + (NFH + f) * 16); *reinterpret_cast<bf16x8*>(apark + f * 1024) = t; }
  }
  asm volatile("s_waitcnt vmcnt(0)" ::: "memory");
  u32x2 kra[4] = {}, krb[4] = {}; float kq = 0.f;
  if constexpr (!ISQ) {
    const bf16* kr = (const bf16*)(ws + OFF_ZA) + (size_t)tok * 704 + 640;
#pragma unroll
    for (int g = 0; g < 4; ++g) { kra[g] = *reinterpret_cast<const u32x2*>(kr + 8 * g + 4 * hi); krb[g] = *reinterpret_cast<const u32x2*>(kr + 32 + 8 * g + 4 * hi); }
#pragma unroll
    for (int g = 0; g < 4; ++g) {
      kq += bflo(kra[g][0]) * bflo(kra[g][0]) + bfhi(kra[g][0]) * bfhi(kra[g][0]) + bflo(kra[g][1]) * bflo(kra[g][1]) + bfhi(kra[g][1]) * bfhi(kra[g][1]);
      kq += bflo(krb[g][0]) * bflo(krb[g][0]) + bfhi(krb[g][0]) * bfhi(krb[g][0]) + bflo(krb[g][1]) * bflo(krb[g][1]) + bfhi(krb[g][1]) * bfhi(krb[g][1]);
    }
  }
  int sc = 0;
#define P2_PART() do {                                                                                                           \
    _Pragma("unroll") for (int nb = 0; nb < NB; ++nb) acc[nb] = f32x16{};                                                       \
    _Pragma("unroll") for (int c = 0; c < NC; ++c) {                                                                            \
      if (c >= DEPTH) asm volatile("s_waitcnt vmcnt(%0)" :: "n"((DEPTH - 1) * LPC) : "memory");                                  \
      __builtin_amdgcn_s_barrier();                                                                                              \
      P2_ISSUE();                                                                                                                \
      const char* wl = lds + sc * STG;                                                                                           \
      _Pragma("unroll") for (int ks = 0; ks < 4; ++ks) {                                                                        \
        const int ch = ks * 2 + hi; bf16x8 afl = {};                                                                             \
        if (c * 4 + ks >= NFH) afl = *reinterpret_cast<const bf16x8*>(apark + (c * 4 + ks - NFH) * 1024);                        \
        _Pragma("unroll") for (int nb = 0; nb < NB; ++nb) {                                                                     \
          const bf16x8 w = *reinterpret_cast<const bf16x8*>(wl + swz128(nb * 32 + r32, ch));                                     \
          acc[nb] = __builtin_amdgcn_mfma_f32_32x32x16_bf16(w, (c * 4 + ks < NFH) ? af[(c * 4 + ks < NFH) ? c * 4 + ks : 0] : afl, acc[nb], 0, 0, 0); \
          if (NB == 6 && nb == 2) SBAR();                                                                                        \
        }                                                                                                                        \
        SBAR();                                                                                                                  \
      }                                                                                                                          \
      sc = (sc == NSTG - 1) ? 0 : sc + 1;                                                                                        \
    } } while (0)
#pragma unroll 1
  for (int pi = 0; pi < NPART; ++pi) {
    f32x16 acc[NB];
    P2_PART();
    asm volatile("s_waitcnt vmcnt(0)" ::: "memory");
    { LAUNDER_TID(t2); const int tok2 = mt * 256 + (t2 >> 6) * 32 + (t2 & 31), hi2 = (t2 >> 5) & 1;
      if constexpr (ISQ) p2_epi_q(p, acc, rs, tok2, half * 4 + pi, hi2);
      else { if (pi & 1) p2_epi_v(p, acc, rs, tok2, half * 4 + (pi >> 1), hi2); else p2_epi_k(p, acc, rs, tok2, half * 4 + (pi >> 1), hi2, kra, krb, kq); } }
  }
  asm volatile("s_waitcnt vmcnt(0)" ::: "memory");
#undef P2_PART
#undef P2_ISSUE
}

DEVI void phase_p2(const Params& p) {
  constexpr int NJ = 768;
  for (int it = 0;; ++it) {
    const int t = remap_tile(it); if (it * (int)gridDim.x >= NJ) break; if (t >= NJ) continue;
    const int mt = t >> 2, sub = t & 3;
    if (sub < 2) p2_job<true>(p, mt, sub); else p2_job<false>(p, mt, sub - 2);
  }
  char* ws = p.ws; LAUNDER_TID(tid);
  const int wid = tid >> 6, lane = tid & 63, nw = gridDim.x * 8;
  for (int r = blockIdx.x * 8 + wid; r < 2 * NMEMROW; r += nw) {
    const int l = r / NMEMROW, row = r % NMEMROW;
    bf16* kp = (bf16*)(ws + OFF_MEMKV + (size_t)l * MEMKV_BYTES) + (size_t)row * 1024;
    const float* gn = p.mem_k_norm + l * 128;
    {
      const int col = lane * 8;
      const u32x4 w = *reinterpret_cast<const u32x4*>(kp + col);
      float v[8]; float ss = 0.f;
#pragma unroll
      for (int j = 0; j < 4; ++j) { v[2 * j] = bflo(w[j]); v[2 * j + 1] = bfhi(w[j]); ss += v[2 * j] * v[2 * j] + v[2 * j + 1] * v[2 * j + 1]; }
      ss += __shfl_xor(ss, 1, 64); ss += __shfl_xor(ss, 2, 64); ss += __shfl_xor(ss, 4, 64); ss += __shfl_xor(ss, 8, 64);
      const float rr = rsqrtf(ss * (1.f / 128.f) + EPS);
      const int d = col & 127;
#pragma unroll
      for (int j = 0; j < 8; ++j) v[j] *= rr * gn[d + j];
      *reinterpret_cast<u32x4*>(kp + col) = u32x4{cvtpk(v[0], v[1]), cvtpk(v[2], v[3]), cvtpk(v[4], v[5]), cvtpk(v[6], v[7])};
    }
  }
}

constexpr int KVBLK = 64;
constexpr float THR = 8.f;
template <int DQK> DEVI int kswz(int row, int colB) {
  if constexpr (DQK == 128) return row * 256 + (colB ^ ((row & 7) << 4));
  else return row * 384 + (colB ^ (((row >> 1) & 7) << 4));
}
DEVI int v_st(int k, int c) { const int kk = (k & ~0xC) | ((k & 4) << 1) | ((k & 8) >> 1); return ((kk >> 3) * 4 + (c >> 5)) * 512 + ((kk & 7) * 32 + (c & 31)) * 2; }
DEVI int v_rd_base(int lane) { return ((lane & 3) << 3) | (((lane >> 2) & 3) << 6) | (((lane >> 4) & 1) << 5) | (((lane >> 5) & 1) << 8); }
constexpr int v_rd_off(int d0, int ks, int half) { return d0 * 512 + ks * 4096 + half * 2048; }
template <int OFF> DEVI s16x4 tr_read(int vb) { s16x4 r; asm volatile("ds_read_b64_tr_b16 %0, %1 offset:%2" : "=&v"(r) : "v"(vb), "i"(OFF) : "memory"); return r; }
template <int D0> DEVI void pv_one(f32x16& od, int vb, bf16x8 pa0, bf16x8 pa1, bf16x8 pa2, bf16x8 pa3) {
  const s16x4 l0 = tr_read<v_rd_off(D0, 0, 0)>(vb), h0 = tr_read<v_rd_off(D0, 0, 1)>(vb), l1 = tr_read<v_rd_off(D0, 1, 0)>(vb), h1 = tr_read<v_rd_off(D0, 1, 1)>(vb);
  const s16x4 l2 = tr_read<v_rd_off(D0, 2, 0)>(vb), h2 = tr_read<v_rd_off(D0, 2, 1)>(vb), l3 = tr_read<v_rd_off(D0, 3, 0)>(vb), h3 = tr_read<v_rd_off(D0, 3, 1)>(vb);
  asm volatile("s_waitcnt lgkmcnt(0)" ::: "memory"); SBAR();
#define PKV(L, H) (bf16x8){L[0], L[1], L[2], L[3], H[0], H[1], H[2], H[3]}
  od = __builtin_amdgcn_mfma_f32_32x32x16_bf16(pa0, PKV(l0, h0), od, 0, 0, 0);
  od = __builtin_amdgcn_mfma_f32_32x32x16_bf16(pa1, PKV(l1, h1), od, 0, 0, 0);
  od = __builtin_amdgcn_mfma_f32_32x32x16_bf16(pa2, PKV(l2, h2), od, 0, 0, 0);
  od = __builtin_amdgcn_mfma_f32_32x32x16_bf16(pa3, PKV(l3, h3), od, 0, 0, 0);
#undef PKV
}
DEVI void pv_d0(f32x16* o, int vb, bf16x8 pa0, bf16x8 pa1, bf16x8 pa2, bf16x8 pa3) {
  pv_one<0>(o[0], vb, pa0, pa1, pa2, pa3); pv_one<1>(o[1], vb, pa0, pa1, pa2, pa3); pv_one<2>(o[2], vb, pa0, pa1, pa2, pa3); pv_one<3>(o[3], vb, pa0, pa1, pa2, pa3);
}
template <int DQK> DEVI void partialSM(f32x16& p0, f32x16& p1, float& m_reg, float& mn, float& alpha) {
  constexpr float SCALE = (DQK == 192) ? 0.07216878364870322f : 0.08838834764831845f;
  constexpr float C = SCALE * LOG2E;
  float pmax = p0[0];
#pragma unroll
  for (int r = 1; r < 16; ++r) pmax = fmaxf(pmax, p0[r]);
#pragma unroll
  for (int r = 0; r < 16; ++r) pmax = fmaxf(pmax, p1[r]);
  pmax = swap_max(pmax);
  if (__builtin_expect(__all(pmax - m_reg <= THR / SCALE), 1)) { mn = m_reg; alpha = 1.f; }
  else { mn = fmaxf(m_reg, pmax); alpha = __builtin_amdgcn_exp2f((m_reg - mn) * C); m_reg = mn; }
  const float mnC = -mn * C;
#pragma unroll
  for (int r = 0; r < 16; ++r) p0[r] = fmaf(p0[r], C, mnC);
#pragma unroll
  for (int r = 0; r < 16; ++r) p1[r] = fmaf(p1[r], C, mnC);
#pragma unroll
  for (int r = 0; r < 16; ++r) p0[r] = __builtin_amdgcn_exp2f(p0[r]);
}
DEVI void finishSM(f32x16& p0, f32x16& p1, float alpha, float& l_reg, bf16x8& pa0, bf16x8& pa1, bf16x8& pa2, bf16x8& pa3) {
#pragma unroll
  for (int r = 0; r < 16; ++r) p1[r] = __builtin_amdgcn_exp2f(p1[r]);
  float ps = 0;
#pragma unroll
  for (int r = 0; r < 16; ++r) ps += p0[r];
#pragma unroll
  for (int r = 0; r < 16; ++r) ps += p1[r];
  ps = swap_sum(ps);
  l_reg = l_reg * alpha + ps;
  PK4(p0, 0, pa0); PK4(p0, 8, pa1); PK4(p1, 0, pa2); PK4(p1, 8, pa3);
}
template <int DQK> DEVI void qkt_acc(f32x16& p0, f32x16& p1, const char* Ks, const bf16x8* qr, int r32, int hi) {
#pragma unroll
  for (int d0 = 0; d0 < DQK / 16; ++d0) { const int cb = (d0 * 16 + hi * 8) * 2;
    const bf16x8 b0 = *reinterpret_cast<const bf16x8*>(Ks + kswz<DQK>(r32, cb));
    const bf16x8 b1 = *reinterpret_cast<const bf16x8*>(Ks + kswz<DQK>(32 + r32, cb));
    p0 = __builtin_amdgcn_mfma_f32_32x32x16_bf16(b0, qr[d0], p0, 0, 0, 0);
    p1 = __builtin_amdgcn_mfma_f32_32x32x16_bf16(b1, qr[d0], p1, 0, 0, 0); }
}
DEVI float silu_f(float g) { return g * __builtin_amdgcn_rcpf(1.f + __builtin_amdgcn_exp2f(-g * LOG2E)); }

template <int DQK, bool QNORM>
DEVI void attn_dense(const bf16* __restrict__ Qb, int ldq, const bf16* __restrict__ Kh, int ldk, const bf16* __restrict__ Vh, int ldv,
                     const bf16* __restrict__ Gb, int ldg, bf16* __restrict__ Ob, int ldo, int seq, const float* __restrict__ qgain, float negM) {
  constexpr int ND0 = DQK / 16, NCH = DQK / 8, KPT = NCH / 8;
  constexpr int SHM_V = 16384, SHM_K = 64 * DQK * 2;
  char* lds = g_smem;
  LAUNDER_TID(tid); const int wid = tid >> 6, lane = tid & 63, r32 = lane & 31, hi = lane >> 5;
  char* V_lds = lds; char* K_lds = lds + 2 * SHM_V;
  float* wsf = (float*)(lds + 2 * SHM_V + 2 * SHM_K) + wid * 64; float* li_l = wsf; float* al_l = wsf + 32;
  float l_reg = 0; f32x16 o[4] = {}; bf16x8 qr[ND0];
  const bf16* Qw = Qb + (size_t)(wid * 32 + r32) * ldq + hi * 8;
#pragma unroll
  for (int d0 = 0; d0 < ND0; ++d0) qr[d0] = *reinterpret_cast<const bf16x8*>(Qw + d0 * 16);
  if constexpr (QNORM) {
    float ss = 0.f;
#pragma unroll
    for (int d0 = 0; d0 < ND0; ++d0) { const u32x4 u = __builtin_bit_cast(u32x4, qr[d0]);
#pragma unroll
      for (int j = 0; j < 4; ++j) { const float a = bflo(u[j]), b = bfhi(u[j]); ss += a * a + b * b; } }
    ss = swap_sum(ss);
    const float rq = rsqrtf(ss * (1.f / DQK) + EPS) * (0.08838834764831845f * LOG2E);
#pragma unroll
    for (int d0 = 0; d0 < ND0; ++d0) { const u32x4 u = __builtin_bit_cast(u32x4, qr[d0]); u32x4 w;
      const f32x4 g0 = *reinterpret_cast<const f32x4*>(qgain + d0 * 16 + hi * 8), g1 = *reinterpret_cast<const f32x4*>(qgain + d0 * 16 + hi * 8 + 4);
      w[0] = cvtpk(bflo(u[0]) * rq * g0[0], bfhi(u[0]) * rq * g0[1]); w[1] = cvtpk(bflo(u[1]) * rq * g0[2], bfhi(u[1]) * rq * g0[3]);
      w[2] = cvtpk(bflo(u[2]) * rq * g1[0], bfhi(u[2]) * rq * g1[1]); w[3] = cvtpk(bflo(u[3]) * rq * g1[2], bfhi(u[3]) * rq * g1[3]);
      qr[d0] = __builtin_bit_cast(bf16x8, w); }
  }
  int kgo[KPT], vgo[2];
#pragma unroll
  for (int i = 0; i < KPT; ++i) { const int q = tid + 512 * i, row = q / NCH, chp = q % NCH;
    const int ch = (DQK == 128) ? (chp ^ (row & 7)) : (chp ^ ((row >> 1) & 7)); kgo[i] = row * ldk + ch * 8; }
#pragma unroll
  for (int i = 0; i < 2; ++i) { const int q = tid + 512 * i, st = q >> 5, kk = (st >> 2) * 8 + ((q >> 2) & 7), cc = q & 3;
    const int k = (kk & ~0xC) | ((kk & 4) << 1) | ((kk & 8) >> 1); vgo[i] = k * ldv + (st & 3) * 32 + cc * 8; }
  const int vb0 = (int)(uintptr_t)V_lds + v_rd_base(lane);
#define GLOAD(b, k0) do { const bf16* kg_ = Kh + (size_t)(k0) * ldk; const bf16* vg_ = Vh + (size_t)(k0) * ldv;               \
    _Pragma("unroll") for (int q_ = 0; q_ < KPT; ++q_) __builtin_amdgcn_global_load_lds((const unsigned*)(kg_ + kgo[q_]), (unsigned*)(K_lds + (b) * SHM_K + q_ * 8192 + tid * 16), 16, 0, 0); \
    _Pragma("unroll") for (int q_ = 0; q_ < 2; ++q_) __builtin_amdgcn_global_load_lds((const unsigned*)(vg_ + vgo[q_]), (unsigned*)(V_lds + (b) * SHM_V + q_ * 8192 + tid * 16), 16, 0, 0); } while (0)
  const int NT = seq / KVBLK;
  __syncthreads();
  GLOAD(0, 0);
  asm volatile("s_waitcnt vmcnt(0)" ::: "memory"); __syncthreads();
  for (int j = 0; j < NT; ++j) {
    const int b = j & 1;
    if (j + 1 < NT) GLOAD(b ^ 1, (j + 1) * KVBLK);
    f32x16 p0, p1; bf16x8 pa0, pa1, pa2, pa3;
#pragma unroll
    for (int r = 0; r < 16; ++r) { p0[r] = negM; p1[r] = negM; }
    qkt_acc<DQK>(p0, p1, K_lds + b * SHM_K, qr, r32, hi);
#pragma unroll
    for (int r = 0; r < 16; ++r) { p0[r] = __builtin_amdgcn_exp2f(p0[r]); p1[r] = __builtin_amdgcn_exp2f(p1[r]); }
    float ps = 0.f;
#pragma unroll
    for (int r = 0; r < 16; ++r) ps += p0[r] + p1[r];
    l_reg += ps;
    PK4(p0, 0, pa0); PK4(p0, 8, pa1); PK4(p1, 0, pa2); PK4(p1, 8, pa3);
    pv_d0(o, vb0 + b * SHM_V, pa0, pa1, pa2, pa3);
    asm volatile("s_waitcnt vmcnt(0)" ::: "memory"); __syncthreads();
  }
  l_reg = swap_sum(l_reg);
  if (hi == 0) li_l[r32] = l_reg; asm volatile("s_waitcnt lgkmcnt(0)" ::: "memory");
  const bf16* Gw = Gb + (size_t)(wid * 32) * ldg; bf16* Ow = Ob + (size_t)(wid * 32) * ldo;
#pragma unroll
  for (int r = 0; r < 16; ++r) { const int orow = crow(r, hi); const float rl = __builtin_amdgcn_rcpf(li_l[orow]);
#pragma unroll
    for (int d0 = 0; d0 < 4; ++d0) {
      const float g = __bfloat162float(Gw[(size_t)orow * ldg + d0 * 32 + r32]);
      Ow[(size_t)orow * ldo + d0 * 32 + r32] = __float2bfloat16(o[d0][r] * rl * silu_f(g));
    } }
#undef GLOAD
}

DEVI void mla_item(const Params& p, int t, float negM) {
  char* ws = p.ws; const int qb = t & 15, h = (t >> 4) & 7, b = t >> 7;
  const size_t tok0 = (size_t)b * SEQ + qb * 256, tokb = (size_t)b * SEQ;
  bf16* Q = (bf16*)(ws + OFF_Q0) + tok0 * 1536 + h * 192;
  attn_dense<192, false>(Q, 1536, (const bf16*)(ws + OFF_K0) + tokb * 1536 + h * 192, 1536, (const bf16*)(ws + OFF_V0) + tokb * 1024 + h * 128, 1024,
                         (const bf16*)p.out + tok0 * 2048 + 512 + h * 128, 2048, Q, 1536, SEQ, nullptr, negM);
}
template <int L> DEVI void mem_item(const Params& p, int t, float negM) {
  char* ws = p.ws; const int qb = t & 15, hm = (t >> 4) & 3, b = t >> 6;
  const size_t tok0 = (size_t)b * SEQ + qb * 256;
  const bf16* zb = (L == 0 ? (const bf16*)p.out : (const bf16*)(ws + OFF_Z1B)) + tok0 * 2048;
  const bf16* kv = (const bf16*)(ws + OFF_MEMKV + (size_t)L * MEMKV_BYTES) + (size_t)b * 256 * 1024 + hm * 128;
  bf16* mo = (bf16*)(ws + (L == 0 ? OFF_MEMO0 : OFF_MEMO1)) + tok0 * 512 + hm * 128;
  attn_dense<128, true>(zb + hm * 128, 2048, kv, 1024, kv + 512, 1024, zb + 512 + 1024 + hm * 128, 2048, mo, 512, 256, p.mem_q_norm + L * 128, negM);
}
DEVI float softmax_shift(const float* __restrict__ gq, const float* __restrict__ gk, int n) {
  float mq = 0.f, mk = 0.f;
  cfloat_p cq = (cfloat_p)(uintptr_t)gq, ck = (cfloat_p)(uintptr_t)gk;
  for (int i = 0; i < n; ++i) { mq = fmaxf(mq, fabsf(cq[i])); mk = fmaxf(mk, fabsf(ck[i])); }
  return -LOG2E * sqrtf((float)n) * mq * mk;
}
DEVI void phase_attn0(const Params& p) {
  const float negM_mla = softmax_shift(p.a_q_norm, p.a_k_norm, 192), negM_mem = softmax_shift(p.mem_q_norm, p.mem_k_norm, 128);
  constexpr int NJ = 1536 + 768;
  for (int it = 0;; ++it) {
    const int t = remap_tile(it); if (it * (int)gridDim.x >= NJ) break; if (t >= NJ) continue;
    if (t < 1536) mla_item(p, t, negM_mla); else mem_item<0>(p, t - 1536, negM_mem);
  }
}

DEVI void phase_knorm(const Params& p) {
  char* ws = p.ws; const bf16* z = (const bf16*)(ws + OFF_Z1A); bf16* kn = (bf16*)(ws + OFF_KN);
  LAUNDER_TID(tid);
  const long gt = (long)blockIdx.x * 512 + tid, gsz = (long)gridDim.x * 512;
  for (long i = gt; i < (long)NTOK * 16; i += gsz) {
    const long tok = i >> 4; const int c = (int)(i & 15) * 8;
    const u32x4 w = *reinterpret_cast<const u32x4*>(z + tok * 1280 + 1024 + c);
    float v[8]; float ss = 0.f;
#pragma unroll
    for (int j = 0; j < 4; ++j) { v[2 * j] = bflo(w[j]); v[2 * j + 1] = bfhi(w[j]); ss += v[2 * j] * v[2 * j] + v[2 * j + 1] * v[2 * j + 1]; }
    ss += __shfl_xor(ss, 1, 64); ss += __shfl_xor(ss, 2, 64); ss += __shfl_xor(ss, 4, 64);
    const float rr = rsqrtf(ss * (1.f / 64.f) + EPS);
    const int d = c & 63;
#pragma unroll
    for (int j = 0; j < 8; ++j) v[j] *= rr * p.b_k_norm[d + j];
    *reinterpret_cast<u32x4*>(kn + tok * 128 + c) = u32x4{cvtpk(v[0], v[1]), cvtpk(v[2], v[3]), cvtpk(v[4], v[5]), cvtpk(v[6], v[7])};
  }
}

constexpr int v_rd_off64(int d0, int ks, int half) { return ((2 * ks + half) * 2 + d0) * 512; }
template <int KS> DEVI void pv_ks64(f32x16* o, int vb, bf16x8 pa) {
  const s16x4 l0 = tr_read<v_rd_off64(0, KS, 0)>(vb), h0 = tr_read<v_rd_off64(0, KS, 1)>(vb), l1 = tr_read<v_rd_off64(1, KS, 0)>(vb), h1 = tr_read<v_rd_off64(1, KS, 1)>(vb);
  asm volatile("s_waitcnt lgkmcnt(0)" ::: "memory"); SBAR();
#define PKV(L, H) (bf16x8){L[0], L[1], L[2], L[3], H[0], H[1], H[2], H[3]}
  o[0] = __builtin_amdgcn_mfma_f32_32x32x16_bf16(pa, PKV(l0, h0), o[0], 0, 0, 0);
  o[1] = __builtin_amdgcn_mfma_f32_32x32x16_bf16(pa, PKV(l1, h1), o[1], 0, 0, 0);
#undef PKV
}
DEVI void swa_item(const Params& p, int t, float bound2) {
  char* ws = p.ws; LAUNDER_PTR(ws); char* lds = g_smem;
  const int qc = t & 127, kvh = (t >> 7) & 1, b = t >> 8;
  LAUNDER_TID(tid); const int wid = tid >> 6, lane = tid & 63, r32 = lane & 31, hi = lane >> 5;
  const int hq = kvh * 8 + wid, i0 = qc * 32; const size_t tokb = (size_t)b * SEQ;
  bf16* z1a = (bf16*)(ws + OFF_Z1A); const bf16* kn = (const bf16*)(ws + OFF_KN); const bf16* z1b = (const bf16*)(ws + OFF_Z1B);
  char* K_lds = lds; char* V_lds = lds + 5 * 8192; float* li_l = (float*)(lds + 10 * 8192) + wid * 64;
  const int ts0 = (i0 - 128) & ~63;
  const int jlo = ts0 < 0 ? (-ts0) >> 6 : 0, jhi = min(5, (SEQ - ts0) >> 6);
  __syncthreads();
  {
    const int krow = tid >> 3, kch = (tid & 7) ^ ((krow >> 1) & 7);
    const int st = tid >> 5, kk = (st >> 1) * 8 + ((tid >> 2) & 7), vk = (kk & ~0xC) | ((kk & 4) << 1) | ((kk & 8) >> 1), vcol = (st & 1) * 32 + (tid & 3) * 8;
    const bf16* kg = kn + (tokb + ts0 + krow) * 128 + kvh * 64 + kch * 8;
    const bf16* vg = z1a + (tokb + ts0 + vk) * 1280 + 1152 + kvh * 64 + vcol;
    for (int j = jlo; j < jhi; ++j) {
      __builtin_amdgcn_global_load_lds((const unsigned*)(kg + (size_t)j * 64 * 128), (unsigned*)(K_lds + j * 8192 + tid * 16), 16, 0, 0);
      __builtin_amdgcn_global_load_lds((const unsigned*)(vg + (size_t)j * 64 * 1280), (unsigned*)(V_lds + j * 8192 + tid * 16), 16, 0, 0);
    }
  }
  const bf16* Gw = z1b + (tokb + i0) * 2048 + 512 + hq * 64 + r32;
  unsigned gpk[16];
#pragma unroll
  for (int r = 0; r < 16; ++r) { const int orow = crow(r, hi);
    const unsigned g0 = *reinterpret_cast<const unsigned short*>(Gw + (size_t)orow * 2048), g1 = *reinterpret_cast<const unsigned short*>(Gw + (size_t)orow * 2048 + 32);
    gpk[r] = g0 | (g1 << 16); }
  bf16* Qw = z1a + (tokb + i0 + r32) * 1280 + hq * 64;
  bf16x8 qr[4];
  { float ss = 0.f; u32x4 u[4];
#pragma unroll
    for (int d0 = 0; d0 < 4; ++d0) { u[d0] = *reinterpret_cast<const u32x4*>(Qw + d0 * 16 + hi * 8);
#pragma unroll
      for (int j = 0; j < 4; ++j) { const float a = bflo(u[d0][j]), c = bfhi(u[d0][j]); ss += a * a + c * c; } }
    ss = swap_sum(ss);
    const float rq = rsqrtf(ss * (1.f / 64.f) + EPS) * (0.125f * LOG2E);
#pragma unroll
    for (int d0 = 0; d0 < 4; ++d0) { u32x4 w;
      const f32x4 g0 = *reinterpret_cast<const f32x4*>(p.b_q_norm + d0 * 16 + hi * 8), g1 = *reinterpret_cast<const f32x4*>(p.b_q_norm + d0 * 16 + hi * 8 + 4);
      w[0] = cvtpk(bflo(u[d0][0]) * rq * g0[0], bfhi(u[d0][0]) * rq * g0[1]); w[1] = cvtpk(bflo(u[d0][1]) * rq * g0[2], bfhi(u[d0][1]) * rq * g0[3]);
      w[2] = cvtpk(bflo(u[d0][2]) * rq * g1[0], bfhi(u[d0][2]) * rq * g1[1]); w[3] = cvtpk(bflo(u[d0][3]) * rq * g1[2], bfhi(u[d0][3]) * rq * g1[3]);
      qr[d0] = __builtin_bit_cast(bf16x8, w); }
  }
  const float slope2 = exp2f(-0.5f * (float)(hq + 1)) * LOG2E, sink2 = p.b_sink[hq] * LOG2E;
  const float negM = -fmaxf(bound2, sink2);
  float l_reg = 0.f;
  f32x16 o[2] = {};
  const int vb0 = (int)(uintptr_t)V_lds + v_rd_base(lane);
  const int query = i0 + r32;
  asm volatile("s_waitcnt vmcnt(0)" ::: "memory"); __syncthreads();
  for (int j = jlo; j < jhi; ++j) {
    const int ts = ts0 + 64 * j; const char* Kt = K_lds + j * 8192;
    f32x16 p0, p1;
#pragma unroll
    for (int r = 0; r < 16; ++r) { p0[r] = negM; p1[r] = negM; }
#pragma unroll
    for (int d0 = 0; d0 < 4; ++d0) { const int ch = d0 * 2 + hi;
      const bf16x8 b0 = *reinterpret_cast<const bf16x8*>(Kt + swz128(r32, ch));
      const bf16x8 b1 = *reinterpret_cast<const bf16x8*>(Kt + swz128(32 + r32, ch));
      p0 = __builtin_amdgcn_mfma_f32_32x32x16_bf16(b0, qr[d0], p0, 0, 0, 0);
      p1 = __builtin_amdgcn_mfma_f32_32x32x16_bf16(b1, qr[d0], p1, 0, 0, 0); }
    const float fb0 = (float)(ts - query + 4 * hi), fb1 = fb0 + 32.f;
    const bool full = (ts - (i0 + 31) >= -128) && (ts + 63 - i0 <= 128);
    float ps = 0.f;
    if (full) {
#pragma unroll
      for (int r = 0; r < 16; ++r) { const float off = (float)((r & 3) + 8 * (r >> 2));
        p0[r] = __builtin_amdgcn_exp2f(fmaf(-slope2, fabsf(fb0 + off), p0[r]));
        p1[r] = __builtin_amdgcn_exp2f(fmaf(-slope2, fabsf(fb1 + off), p1[r]));
        ps += p0[r] + p1[r]; }
    } else {
#pragma unroll
      for (int r = 0; r < 16; ++r) { const float off = (float)((r & 3) + 8 * (r >> 2));
        const float e0 = fabsf(fb0 + off), e1 = fabsf(fb1 + off);
        p0[r] = e0 <= 128.f ? __builtin_amdgcn_exp2f(fmaf(-slope2, e0, p0[r])) : 0.f;
        p1[r] = e1 <= 128.f ? __builtin_amdgcn_exp2f(fmaf(-slope2, e1, p1[r])) : 0.f;
        ps += p0[r] + p1[r]; }
    }
    l_reg += ps;
    const int vb = vb0 + j * 8192; bf16x8 pa;
    PK4(p0, 0, pa); pv_ks64<0>(o, vb, pa); PK4(p0, 8, pa); pv_ks64<1>(o, vb, pa);
    PK4(p1, 0, pa); pv_ks64<2>(o, vb, pa); PK4(p1, 8, pa); pv_ks64<3>(o, vb, pa);
  }
  l_reg = swap_sum(l_reg) + __builtin_amdgcn_exp2f(sink2 + negM);
  if (hi == 0) li_l[r32] = l_reg; asm volatile("s_waitcnt lgkmcnt(0)" ::: "memory");
  bf16* Ow = z1a + (tokb + i0) * 1280 + hq * 64 + r32;
#pragma unroll
  for (int r = 0; r < 16; ++r) { const int orow = crow(r, hi); const float rl = __builtin_amdgcn_rcpf(li_l[orow]);
    Ow[(size_t)orow * 1280] = __float2bfloat16(o[0][r] * rl * silu_f(bflo(gpk[r])));
    Ow[(size_t)orow * 1280 + 32] = __float2bfloat16(o[1][r] * rl * silu_f(bfhi(gpk[r])));
  }
}
DEVI void phase_attn1(const Params& p) {
  const float negM_mem = softmax_shift(p.mem_q_norm + 128, p.mem_k_norm + 128, 128), bound2_swa = -softmax_shift(p.b_q_norm, p.b_k_norm, 64);
  constexpr int NJ = 3072 + 768;
  for (int it = 0;; ++it) {
    const int t = remap_tile(it); if (it * (int)gridDim.x >= NJ) break; if (t >= NJ) continue;
    if (t < 768) mem_item<1>(p, t, negM_mem); else swa_item(p, t - 768, bound2_swa);
  }
}

#define XB_TMO      128
#define XB_XCNT(j)  (256  + 64 * (j))
#define XB_XSUB(j)  (1280 + 64 * (j))
#define XB_XGEN(j)  (2304 + 64 * (j))
#define XB_TOP      3328
#define XB_TOPGEN   3392
#define XB_SPIN_CAP (1u << 20)
#define LAS __attribute__((address_space(3)))
DEVI unsigned xb_ld(unsigned* p)              { return __hip_atomic_load(p, __ATOMIC_RELAXED, __HIP_MEMORY_SCOPE_AGENT); }
DEVI unsigned xb_add(unsigned* p, unsigned v) { return __hip_atomic_fetch_add(p, v, __ATOMIC_RELAXED, __HIP_MEMORY_SCOPE_AGENT); }
DEVI unsigned xb_xcc_id() { return (unsigned)__builtin_amdgcn_s_getreg((3 << 11) | 20) & 0xFu; }
#define XB_SPIN(cond, bar) do { unsigned _sp = 0; while (cond) { __builtin_amdgcn_s_sleep(1); \
    if ((++_sp & 255u) == 0u) { if (xb_ld(&(bar)[XB_TMO])) break; if (_sp > XB_SPIN_CAP) { atomicAdd(&(bar)[XB_TMO], 1u); break; } } } } while (0)
struct XcdBarrier { unsigned* bar; unsigned x; volatile LAS unsigned* st; };
DEVI XcdBarrier xcd_barrier_post(unsigned* bar, volatile LAS unsigned* st) {
  XcdBarrier b; b.bar = bar; b.x = xb_xcc_id(); b.st = st;
  if (threadIdx.x == 0) (void)xb_add(&bar[XB_XCNT(b.x)], 1u);
  return b;
}
DEVI void xcd_barrier_complete(unsigned* bar, unsigned x, unsigned& nloc, unsigned& nx) {
  const unsigned G = gridDim.x * gridDim.y * gridDim.z;
  unsigned sum, cnt, mine, sp = 0u;
  for (;;) {
    sum = 0u; cnt = 0u; mine = 0u;
#pragma unroll
    for (unsigned j = 0; j < 16; ++j) { const unsigned c = xb_ld(&bar[XB_XCNT(j)]); sum += c; cnt += (c > 0u) ? 1u : 0u; mine = (j == x) ? c : mine; }
    if (sum == G) break;
    __builtin_amdgcn_s_sleep(1);
    if ((++sp & 255u) == 0u) { if (xb_ld(&bar[XB_TMO])) break; if (sp > XB_SPIN_CAP) { atomicAdd(&bar[XB_TMO], 1u); break; } }
  }
  nloc = mine > 0u ? mine : 1u; nx = cnt > 0u ? cnt : 1u;
}
DEVI void xcd_barrier(const XcdBarrier& b) {
  asm volatile("s_waitcnt vmcnt(0)" ::: "memory");
  __syncthreads();
  if (threadIdx.x == 0) {
    unsigned* bar = b.bar;
    __builtin_amdgcn_s_waitcnt(0);
    unsigned nloc = b.st[0], nx = b.st[1];
    if (nloc == 0u) { xcd_barrier_complete(bar, b.x, nloc, nx); b.st[0] = nloc; b.st[1] = nx; }
    const unsigned old = xb_add(&bar[XB_XSUB(b.x)], 1u);
    const unsigned gen = old / nloc;
    if (old + 1u == (gen + 1u) * nloc) {
      __builtin_amdgcn_fence(__ATOMIC_RELEASE, "agent");
      asm volatile("s_waitcnt vmcnt(0)" ::: "memory");
      const unsigned og = xb_add(&bar[XB_TOP], 1u);
      const unsigned tg = og / nx;
      if (og + 1u == (tg + 1u) * nx) xb_add(&bar[XB_TOPGEN], 1u);
      else XB_SPIN(xb_ld(&bar[XB_TOPGEN]) == tg, bar);
      __builtin_amdgcn_fence(__ATOMIC_ACQUIRE, "agent");
      xb_add(&bar[XB_XGEN(b.x)], 1u);
      asm volatile("s_waitcnt vmcnt(0)" ::: "memory");
    } else {
      XB_SPIN(xb_ld(&bar[XB_XGEN(b.x)]) == gen, bar);
      __builtin_amdgcn_fence(__ATOMIC_ACQUIRE, "agent");
      asm volatile("s_waitcnt vmcnt(0)" ::: "memory");
    }
  }
  __syncthreads();
}
template <int PH> DEVI void run_phase(const Params& p) {
  if constexpr (PH == 0) phase_prep(p);
  else if constexpr (PH == 1) phase_gemm1(p);
  else if constexpr (PH == 2) phase_p2(p);
  else if constexpr (PH == 3) phase_attn0(p);
  else if constexpr (PH == 4) phase_gemm_simple<G_OUT0>(p, 4);
  else if constexpr (PH == 5) phase_gemm_simple<G_Z1>(p, 13);
  else if constexpr (PH == 6) phase_knorm(p);
  else if constexpr (PH == 7) phase_attn1(p);
  else phase_gemm_simple<G_OUT1>(p, 4);
}
#if MK_COOP
__global__ __launch_bounds__(512) void mega_coop(Params p) {
  cg::grid_group grid = cg::this_grid();
  __shared__ uint4 xb_words;
  if (threadIdx.x == 0) xb_words = uint4{0u, 0u, 0u, 0u};
  __syncthreads();
  const XcdBarrier xb = xcd_barrier_post((unsigned*)(p.ws + OFF_BAR), (volatile LAS unsigned*)&xb_words);
  if (p.ws == nullptr) grid.sync();
  phase_prep(p); xcd_barrier(xb);
  phase_gemm1(p); xcd_barrier(xb);
  phase_p2(p); xcd_barrier(xb);
  phase_attn0(p); xcd_barrier(xb);
  phase_gemm_simple<G_OUT0>(p, 4); xcd_barrier(xb);
  phase_gemm_simple<G_Z1>(p, 13); xcd_barrier(xb);
  phase_knorm(p); xcd_barrier(xb);
  phase_attn1(p); xcd_barrier(xb);
  phase_gemm_simple<G_OUT1>(p, 4);
}
#endif
template <int PH> __global__ __launch_bounds__(512) void mega_phase(Params p) { run_phase<PH>(p); }

extern "C" void kernel_launch(void* const* d_in, const int* in_sizes, int n_in, void* d_out, int out_size, void* d_ws, size_t ws_size, hipStream_t stream) {
  static int grid = 0;
  if (grid == 0) {
    if (n_in != 21 || out_size != NTOK * 1024 || ws_size < WS_NEED) { fprintf(stderr, "kernel_launch: unexpected shapes n_in %d out %d ws %zu\n", n_in, out_size, ws_size); grid = -1; return; }
    int dev = 0, cus = 0, per_cu = 0;
    (void)hipGetDevice(&dev); (void)hipDeviceGetAttribute(&cus, hipDeviceAttributeMultiprocessorCount, dev);
#if MK_COOP
    (void)hipFuncSetAttribute((const void*)mega_coop, hipFuncAttributeMaxDynamicSharedMemorySize, LDS_BYTES);
    (void)hipOccupancyMaxActiveBlocksPerMultiprocessor(&per_cu, (const void*)mega_coop, 512, LDS_BYTES);
#else
#define SETATTR(PH) (void)hipFuncSetAttribute((const void*)mega_phase<PH>, hipFuncAttributeMaxDynamicSharedMemorySize, LDS_BYTES)
    SETATTR(0); SETATTR(1); SETATTR(2); SETATTR(3); SETATTR(4); SETATTR(5); SETATTR(6); SETATTR(7); SETATTR(8);
    per_cu = 1;
#endif
    if (per_cu < 1) { fprintf(stderr, "kernel_launch: occupancy query says %d blocks/CU\n", per_cu); per_cu = 1; }
    grid = cus * 1;
  }
  if (grid < 0) return;
  { static const int exp_sz[21] = {8*4096*1024, 4*4096*1024, 8*256*1024, 4*256*1024, 2*1024, 2*1536*1024, 2*1024, 2*1024*1024, 2*128, 2*128,
      1024*2752, 384, 384*1536, 256, 256*2048, 192, 192, 1024*3328, 64, 64, 16};
    for (int i = 0; i < 21; ++i) if (in_sizes[i] != exp_sz[i]) { fprintf(stderr, "in_sizes[%d] = %d != %d\n", i, in_sizes[i], exp_sz[i]);
      return; } }
  Params p{};
  const float** pp = (const float**)&p;
  for (int i = 0; i < 21; ++i) pp[i] = (const float*)d_in[i];
  p.out = (float*)d_out; p.ws = (char*)d_ws;
#if MK_COOP
  (void)hipMemsetAsync((char*)d_ws + OFF_BAR, 0, 16384, stream);
  void* args[] = {&p};
  hipError_t e = hipLaunchCooperativeKernel((const void*)mega_coop, dim3(grid), dim3(512), args, LDS_BYTES, stream);
  if (e != hipSuccess) fprintf(stderr, "cooperative launch failed: %s (grid %d)\n", hipGetErrorString(e), grid);
#else
#define LAUNCH(PH) hipLaunchKernelGGL(mega_phase<PH>, dim3(grid), dim3(512), LDS_BYTES, stream, p)
  LAUNCH(0); LAUNCH(1); LAUNCH(2); LAUNCH(3); LAUNCH(4); LAUNCH(5); LAUNCH(6); LAUNCH(7); LAUNCH(8);
#endif
}
```
